# Optimizing an MI355X kernel written in HIP

```python
import jax, jax.numpy as jnp
from jax import lax
import numpy as np

D_MODEL = 2048
BATCH = 4
SEQ = 2048
DEPTH = 1
DEC_BATCH = 128
DEC_SEQ = 1
PAST_LEN = 16384
PAGE_SIZE = 128

D_MIX = D_MODEL
D_A = D_MIX // 2
D_B = D_MIX - D_A
EXPAND = 128
H_A = D_A // EXPAND
DK = EXPAND
DV = D_A // H_A
CONV_W = 31
D_FF = ((8 * D_MODEL // 3 + 255) // 256) * 256
D_IN = 4 * D_A + 2 * D_B
N_MOD = 9
CHUNK = 32
HALF = 0.5
EPS = 1e-6

kernel_name = "hymba_hgrn2_conformer_macaron_adaln_step"

F32 = jnp.float32


def _rmsnorm(x, g):
    xf = x.astype(F32)
    y = xf * lax.rsqrt(jnp.mean(xf * xf, axis=-1, keepdims=True) + EPS)
    return (y * g.astype(F32)).astype(x.dtype)


def _layernorm(x, g, b):
    xf = x.astype(F32)
    mu = jnp.mean(xf, axis=-1, keepdims=True)
    xc = xf - mu
    var = jnp.mean(xc * xc, axis=-1, keepdims=True)
    return (xc * lax.rsqrt(var + EPS) * g.astype(F32) + b.astype(F32)).astype(x.dtype)


def _modulate(h, shift, scale):
    return h * (1 + scale[:, None, :]) + shift[:, None, :]


def _swiglu(h, w_up, w_down):
    a, b = jnp.split(h @ w_up, 2, axis=-1)
    return (jax.nn.silu(a) * b) @ w_down


def _hgrn2(q, k, v, logf, s0):
    bsz, L = q.shape[0], q.shape[1]
    c = CHUNK if L >= CHUNK else L
    n = -(-L // c)
    pad = n * c - L
    if pad:
        pw = ((0, 0), (0, pad), (0, 0), (0, 0))
        q, k, v, logf = [jnp.pad(t, pw) for t in (q, k, v, logf)]

    def blocks(t):
        return t.reshape(bsz, n, c, H_A, t.shape[-1]).transpose(1, 0, 3, 2, 4)

    causal = jnp.tril(jnp.ones((c, c), dtype=bool))[:, :, None]

    def step(S, blk):
        qc, kc, vc, lf = blk
        b = jnp.cumsum(lf, axis=2)
        o_inter = jnp.einsum('bhtk,bhkv->bhtv', qc * jnp.exp(b), S)
        diff = b[:, :, :, None, :] - b[:, :, None, :, :]
        decay = jnp.exp(jnp.where(causal, diff, -jnp.inf))
        att = jnp.einsum('bhtsk,bhsk->bhts', qc[:, :, :, None, :] * decay, kc)
        o = o_inter + jnp.einsum('bhts,bhsv->bhtv', att, vc)
        b_last = b[:, :, -1:, :]
        S_new = jnp.exp(b_last[:, :, 0, :])[..., None] * S + jnp.einsum(
            'bhsk,bhsv->bhkv', kc * jnp.exp(b_last - b), vc)
        return S_new, o

    S, o = lax.scan(step, s0, (blocks(q), blocks(k), blocks(v), blocks(logf)))
    o = o.transpose(1, 0, 3, 2, 4).reshape(bsz, n * c, H_A, DV)[:, :L]
    return o, S


def _dwconv(u_ext, w, b):
    y = lax.conv_general_dilated(
        u_ext, w[:, None, :].astype(u_ext.dtype), window_strides=(1,), padding='VALID',
        dimension_numbers=('NWC', 'WIO', 'NWC'), feature_group_count=u_ext.shape[-1])
    return y + b


def _layer(x, c, s_hgrn, conv_buf, lb, w_ada, b_ada, norm_g, w_f1_up, w_f1_down, w_in, b_in,
           g_norm_a, conv_w, conv_b, ln_g, ln_b, w_out, w_f2_up, w_f2_down):
    bsz, L, _ = x.shape
    mod = jax.nn.silu(c) @ w_ada + b_ada
    sh1, sc1, gt1, sh2, sc2, gt2, sh3, sc3, gt3 = jnp.split(mod, N_MOD, axis=-1)

    h = _modulate(_rmsnorm(x, norm_g[0]), sh1, sc1)
    x = x + HALF * gt1[:, None, :] * _swiglu(h, w_f1_up, w_f1_down)

    h = _modulate(_rmsnorm(x, norm_g[1]), sh2, sc2)
    z = h @ w_in + b_in
    zq, zf, zi, zg, za, zb = jnp.split(
        z, [D_A, 2 * D_A, 3 * D_A, 4 * D_A, 4 * D_A + D_B], axis=-1)

    def heads(t):
        return t.astype(F32).reshape(bsz, L, H_A, -1)
    lbh = lb.reshape(H_A, DK)
    zf_h = heads(zf)
    q = jax.nn.silu(heads(zq))
    logf = jnp.logaddexp(jnp.log(lbh), jnp.log1p(-lbh) + jax.nn.log_sigmoid(zf_h))
    k = (1 - lbh) * jax.nn.sigmoid(-zf_h)
    v = heads(zi)
    o, s_new = _hgrn2(q, k, v, logf, s_hgrn.astype(F32))
    o = o * lax.rsqrt(jnp.mean(o * o, axis=-1, keepdims=True) + EPS)
    o = (o.reshape(bsz, L, D_A) * g_norm_a.astype(F32)
         * jax.nn.silu(zg.astype(F32))).astype(x.dtype)

    u = za * jax.nn.sigmoid(zb)
    u_ext = jnp.concatenate([conv_buf.astype(u.dtype), u], axis=1)
    y = jax.nn.silu(_layernorm(_dwconv(u_ext, conv_w, conv_b), ln_g, ln_b))

    mix = jnp.concatenate([o, y.astype(x.dtype)], axis=-1) @ w_out
    x = x + gt2[:, None, :] * mix

    h = _modulate(_rmsnorm(x, norm_g[2]), sh3, sc3)
    x = x + HALF * gt3[:, None, :] * _swiglu(h, w_f2_up, w_f2_down)
    return x, s_new, u_ext[:, -(CONV_W - 1):]


def setup_inputs(seed: int = 0) -> dict:
    key = jax.random.key(seed)
    ks = iter(jax.random.split(key, 32))
    nrm = lambda shape, s: jax.random.normal(next(ks), shape, F32) * s
    D = D_MODEL
    return {
        "x_prompt": nrm((BATCH, SEQ, D), 1.0),
        "x_sample": nrm((DEC_BATCH, DEC_SEQ, D), 1.0),
        "state_hgrn": nrm((DEPTH, DEC_BATCH, H_A, DK, DV), 0.5),
        "state_conv": nrm((DEPTH, DEC_BATCH, CONV_W - 1, D_B), 0.5),
        "c_prompt": nrm((BATCH, D), 1.0),
        "c_sample": nrm((DEC_BATCH, D), 1.0),
        "lb_logits": nrm((DEPTH + 1, D_A), 0.5),
        "w_ada": nrm((DEPTH, D, N_MOD * D), 0.5 * D ** -0.5),
        "b_ada": nrm((DEPTH, N_MOD * D), 0.05),
        "norm_g": 1.0 + nrm((DEPTH, 3, D), 0.05),
        "w_f1_up": nrm((DEPTH, D, 2 * D_FF), D ** -0.5),
        "w_f1_down": nrm((DEPTH, D_FF, D), D_FF ** -0.5),
        "w_in": nrm((DEPTH, D, D_IN), D ** -0.5),
        "b_in": nrm((DEPTH, D_IN), 0.02),
        "g_norm_a": 1.0 + nrm((DEPTH, D_A), 0.05),
        "conv_w": nrm((DEPTH, CONV_W, D_B), CONV_W ** -0.5),
        "conv_b": nrm((DEPTH, D_B), 0.02),
        "ln_g": 1.0 + nrm((DEPTH, D_B), 0.05),
        "ln_b": nrm((DEPTH, D_B), 0.02),
        "w_out": nrm((DEPTH, D_MIX, D), D_MIX ** -0.5),
        "w_f2_up": nrm((DEPTH, D, 2 * D_FF), D ** -0.5),
        "w_f2_down": nrm((DEPTH, D_FF, D), D_FF ** -0.5),
        "final_g": 1.0 + nrm((D,), 0.05),
    }


def reference(x_prompt, x_sample, state_hgrn, state_conv, c_prompt, c_sample, lb_logits,
              w_ada, b_ada, norm_g, w_f1_up, w_f1_down, w_in, b_in, g_norm_a, conv_w, conv_b,
              ln_g, ln_b, w_out, w_f2_up, w_f2_down, final_g):
    lbs = jnp.cumsum(jax.nn.softmax(lb_logits.astype(F32), axis=0), axis=0)
    bp = x_prompt.shape[0]
    s0 = jnp.zeros((bp, H_A, DK, DV), F32)
    buf0 = jnp.zeros((bp, CONV_W - 1, D_B), x_prompt.dtype)
    xp, xs = x_prompt, x_sample
    hp, hs, cp, cs = [], [], [], []
    for l in range(DEPTH):
        wl = (lbs[l], w_ada[l], b_ada[l], norm_g[l], w_f1_up[l], w_f1_down[l], w_in[l], b_in[l],
              g_norm_a[l], conv_w[l], conv_b[l], ln_g[l], ln_b[l], w_out[l], w_f2_up[l],
              w_f2_down[l])
        xp, sp, bufp = _layer(xp, c_prompt, s0, buf0, *wl)
        xs, ss, bufs = _layer(xs, c_sample, state_hgrn[l], state_conv[l], *wl)
        hp.append(sp)
        hs.append(ss)
        cp.append(bufp)
        cs.append(bufs)
    y_prompt = _rmsnorm(xp, final_g)
    y_sample = _rmsnorm(xs, final_g)
    new_hgrn_prompt = jnp.stack(hp, axis=0).astype(state_hgrn.dtype)
    new_hgrn_sample = jnp.stack(hs, axis=0).astype(state_hgrn.dtype)
    new_conv_prompt = jnp.stack(cp, axis=0).astype(state_conv.dtype)
    new_conv_sample = jnp.stack(cs, axis=0).astype(state_conv.dtype)
    return (y_prompt, y_sample, new_hgrn_prompt, new_hgrn_sample, new_conv_prompt, new_conv_sample)
```

```cpp
#include <hip/hip_runtime.h>
#include <hip/hip_cooperative_groups.h>
#include <cstdio>
namespace cg = cooperative_groups;

#define LAS __attribute__((address_space(3)))
typedef unsigned short bf16_t;
typedef short bf16x8 __attribute__((ext_vector_type(8)));
typedef float f32x4 __attribute__((ext_vector_type(4)));
typedef float f32x2 __attribute__((ext_vector_type(2)));
typedef unsigned u32x4 __attribute__((ext_vector_type(4)));
typedef unsigned u32x2 __attribute__((ext_vector_type(2)));

constexpr int D = 2048, NBATCH = 4, SEQ = 2048, MP = NBATCH * SEQ, MS = 128, MR = MP + MS, MPAD = 8448;
constexpr int DFF = 5632, DIN = 6144, DA = 1024, NH = 8, NMOD = 9 * D, CW = 31;
constexpr float EPS = 1e-6f;
constexpr int NTHR = 512;

constexpr size_t SZ_WUP = (size_t)2 * DFF * D * 2, SZ_WDN = (size_t)D * DFF * 2, SZ_WIN = (size_t)DIN * D * 2, SZ_WOUT = (size_t)D * D * 2;
constexpr size_t WS_WUP1 = 0, WS_WDN1 = WS_WUP1 + SZ_WUP, WS_WIN = WS_WDN1 + SZ_WDN, WS_WOUT = WS_WIN + SZ_WIN, WS_WUP2 = WS_WOUT + SZ_WOUT, WS_WDN2 = WS_WUP2 + SZ_WUP;
constexpr size_t WS_MOD = WS_WDN2 + SZ_WDN;
constexpr size_t WS_H = WS_MOD + (size_t)144 * NMOD * 4;
constexpr size_t WS_G = WS_H + (size_t)MPAD * D * 2;
constexpr size_t WS_X = WS_G + (size_t)MPAD * DFF * 2;
constexpr size_t WS_Q = WS_X + (size_t)MPAD * D * 4;
constexpr size_t WS_K = WS_Q + (size_t)MPAD * DA * 2;
constexpr size_t WS_V = WS_K + (size_t)MPAD * DA * 2;
constexpr size_t WS_GT = WS_V + (size_t)MPAD * DA * 2;
constexpr size_t WS_U = WS_GT + (size_t)MPAD * DA * 2;
constexpr size_t WS_LF = WS_U + (size_t)MPAD * DA * 2;
constexpr size_t WS_OMIX = WS_LF + (size_t)MPAD * DA * 4;
constexpr size_t WS_LLOC = WS_OMIX + (size_t)MPAD * D * 2;
constexpr size_t WS_DLOC = WS_LLOC + (size_t)32 * 8 * 128 * 128 * 4;
constexpr size_t WS_PART = WS_DLOC + (size_t)32 * 8 * 128 * 4;
constexpr int NS_DN = 22, NS_IN = 8, NS_OUT = 8;
constexpr size_t WS_BAR = WS_PART + (size_t)8 * 128 * DIN * 4;
constexpr size_t WS_END = WS_BAR + 16384;
static_assert((size_t)NS_DN * 128 * D * 4 <= (size_t)8 * 128 * DIN * 4, "partial buffer");

constexpr size_t OUT_Y = 0, OUT_HP = (size_t)MR * D, OUT_HS = OUT_HP + (size_t)NBATCH * NH * 128 * 128, OUT_CP = OUT_HS + (size_t)MS * NH * 128 * 128,
                 OUT_CS = OUT_CP + (size_t)NBATCH * 30 * 1024;

struct Args {
    const float* in[23];
    float* out;
    unsigned char* ws;
    int never; int pad;
};

typedef __bf16 bf16x2_t __attribute__((ext_vector_type(2)));
__device__ __forceinline__ unsigned cvt_pk_bf16(float lo, float hi) { const f32x2 v = {lo, hi}; const bf16x2_t b = __builtin_convertvector(v, bf16x2_t); return __builtin_bit_cast(unsigned, b); }
__device__ __forceinline__ float bf_lo(unsigned u) { return __uint_as_float(u << 16); }
__device__ __forceinline__ float bf_hi(unsigned u) { return __uint_as_float(u & 0xffff0000u); }
__device__ __forceinline__ float bf2f(bf16_t b) { return __uint_as_float(((unsigned)b) << 16); }
__device__ __forceinline__ bf16_t f2bf(float f) { return (bf16_t)(cvt_pk_bf16(f, 0.f) & 0xffffu); }
__device__ __forceinline__ float sigmoidf_(float x) { return __builtin_amdgcn_rcpf(1.0f + __expf(-x)); }
__device__ __forceinline__ float siluf_(float x) { return x * sigmoidf_(x); }
__device__ __forceinline__ int modrow_of(int row) { return row < MP ? (row >> 11) : (4 + row - MP); }

namespace pg8 {
constexpr int BM = 256, BK = 64, HALF = 128, HTB = HALF * BK * 2, STAGE_BYTES = 8 * HTB, NXCD = 8, WGM = 8;
__device__ __forceinline__ int lds_byte(int r, int c) { const int st = (r >> 4) * 2 + (c >> 5), rr = r & 15, cc = c & 31, ob = rr * 64 + cc * 2; return st * 1024 + (ob ^ (((ob >> 9) & 1) << 5)); }
__device__ __forceinline__ void stage_rc(int b, int& R, int& C) { const int st = b / 1024, sb = b % 1024, swz = sb ^ (((sb >> 9) & 1) << 5); R = (st >> 1) * 16 + swz / 64; C = (st & 1) * 32 + (swz % 64) / 2; }
__device__ __forceinline__ int perm32(int rho) { const int n = rho >> 4, i = rho & 15; return 8 * (i >> 2) + 4 * n + (i & 3); }

struct Unit { int pm, pn, kt0, nt, split; };
struct Gemm { const bf16_t* A; const bf16_t* Bt; int M, N, K; };

struct StaticOrder {
    int nM, nN, nwg, G, c, nt_full, nextra, nNx, ntx, nsplit;
    __device__ void init(int M, int N, int K, int G_, int c_, int nsplit_) { nM = M / BM; nN = N / BM; nwg = nM * nN; G = G_; c = c_; nt_full = K / BK; nNx = nN; nsplit = nsplit_; nextra = nNx * nsplit; ntx = nt_full / nsplit; }
    __device__ bool next(int i, Unit& u) const {
        const long L = (long)i * G + c;
        if (L >= nwg) { const int e = (int)(L - nwg); if (e >= nextra) return false; const int sp = e / nNx; u.pm = 32; u.pn = e - sp * nNx; u.kt0 = sp * ntx; u.nt = ntx; u.split = nsplit > 1 ? sp : -1; return true; }
        int wgid = (int)L; { const int q = nwg / NXCD, r = nwg % NXCD, xcd = wgid % NXCD, off = wgid / NXCD; wgid = (xcd < r ? xcd * (q + 1) : r * (q + 1) + (xcd - r) * q) + off; }
        const int nig = WGM * nN, gid = wgid / nig, fm = gid * WGM, gsz = (nM - fm) < WGM ? (nM - fm) : WGM;
        u.pm = fm + ((wgid % nig) % gsz); u.pn = (wgid % nig) / gsz; u.kt0 = 0; u.nt = nt_full; u.split = -1; return true;
    }
};

template <class Epi, class Sched>
__device__ __forceinline__ void gemm_phase(LAS unsigned char* lds, const Gemm g, const Sched& S, const Epi& E) {
    int tid = threadIdx.x; asm volatile("" : "+v"(tid));
    const int wid = __builtin_amdgcn_readfirstlane(tid >> 6), lane = tid & 63, wr = wid >> 2, wc = wid & 3, fr = lane & 15, fq = lane >> 4;
    const int K = g.K;
    unsigned voffA[2], voffB[2];
#pragma unroll
    for (int i = 0; i < 2; ++i) { int R, C; stage_rc(tid * 16 + i * 8192, R, C); const int Rb = Epi::PERM ? ((R & ~31) + perm32(R & 31)) : R;
        voffA[i] = (unsigned)(R * K + C) * 2u; voffB[i] = (unsigned)(Rb * K + C) * 2u; }
    const size_t kstep = (size_t)(BK * 2);
    const size_t hstep = (size_t)HALF * K * 2;
    const size_t tstep = 2 * hstep;
    const unsigned ldsw = (unsigned)wid * 1024u;
    const int aoff = lds_byte(wr * 64 + fr, fq * 8), boff = lds_byte(wc * 32 + fr, fq * 8);
#define PG8_SA(b, h) (((b) * 2 + (h)) * HTB)
#define PG8_SB(b, h) ((4 + (b) * 2 + (h)) * HTB)
#define PG8_STAGE(bufoff, gbase, voff) do { _Pragma("unroll") for (int _i = 0; _i < 2; ++_i) \
        __builtin_amdgcn_global_load_lds((const unsigned*)((const char*)(gbase) + (voff)[_i]), (LAS unsigned*)(lds + (bufoff) + ldsw + _i * 8192), 16, 0, 0); } while (0)
#define PG8_LDA(dst, b, h) do { _Pragma("unroll") for (int m = 0; m < 4; ++m) _Pragma("unroll") for (int k = 0; k < 2; ++k) dst[m][k] = *(const LAS bf16x8*)(lds + PG8_SA(b, h) + aoff + m * 2048 + k * 1024); } while (0)
#define PG8_LDB(dst, b, h) do { _Pragma("unroll") for (int n = 0; n < 2; ++n) _Pragma("unroll") for (int k = 0; k < 2; ++k) dst[n][k] = *(const LAS bf16x8*)(lds + PG8_SB(b, h) + boff + n * 2048 + k * 1024); } while (0)
#define PG8_MMA(ai, bj, At, Bt) do { __builtin_amdgcn_s_setprio(1); _Pragma("unroll") for (int m = 0; m < 4; ++m) _Pragma("unroll") for (int n = 0; n < 2; ++n) _Pragma("unroll") for (int k = 0; k < 2; ++k) \
        acc[ai][bj][m][n] = __builtin_amdgcn_mfma_f32_16x16x32_bf16(Bt[n][k], At[m][k], acc[ai][bj][m][n], 0, 0, 0); __builtin_amdgcn_s_setprio(0); } while (0)
#define PG8_WAIT_V(n) asm volatile("s_waitcnt vmcnt(" #n ")" ::: "memory")
#define PG8_WAIT_L(n) asm volatile("s_waitcnt lgkmcnt(" #n ")" ::: "memory")
#define PG8_BAR __builtin_amdgcn_s_barrier()
#define PG8_SCHED __builtin_amdgcn_sched_barrier(0)
    Unit cur, nxt; int ui = 0;
    if (!S.next(0, cur)) return;
    f32x4 acc[2][2][4][2];
#pragma unroll
    for (int a = 0; a < 2; ++a)
#pragma unroll
        for (int b = 0; b < 2; ++b)
#pragma unroll
            for (int m = 0; m < 4; ++m)
#pragma unroll
                for (int n = 0; n < 2; ++n) acc[a][b][m][n] = (f32x4){0.f, 0.f, 0.f, 0.f};
    bf16x8 At[4][2], B0[2][2], B1[2][2];
    const char* cA = (const char*)g.A + (size_t)cur.pm * tstep + (size_t)cur.kt0 * kstep; const char* cB = (const char*)g.Bt + (size_t)cur.pn * tstep + (size_t)cur.kt0 * kstep;
    PG8_STAGE(PG8_SB(0, 0), cB, voffB); PG8_STAGE(PG8_SA(0, 0), cA, voffA); PG8_STAGE(PG8_SB(0, 1), cB + hstep, voffB); PG8_STAGE(PG8_SA(0, 1), cA + hstep, voffA);
    if (wr == 1) PG8_BAR;
    PG8_WAIT_V(4); PG8_BAR;
    PG8_STAGE(PG8_SB(1, 0), cB + kstep, voffB); PG8_STAGE(PG8_SA(1, 0), cA + kstep, voffA); PG8_STAGE(PG8_SB(1, 1), cB + hstep + kstep, voffB);
    PG8_WAIT_V(6); PG8_BAR;
    for (;;) {
        const bool has_next = S.next(ui + 1, nxt);
        const char* nA = has_next ? (const char*)g.A + (size_t)nxt.pm * tstep + (size_t)nxt.kt0 * kstep : cA; const char* nB = has_next ? (const char*)g.Bt + (size_t)nxt.pn * tstep + (size_t)nxt.kt0 * kstep : cB;
        const int nt = cur.nt;
        for (int t = 0; t < nt; t += 2) {
            const bool last = (t == nt - 2);
            const char* a1 = cA + (size_t)(t + 1) * kstep;
            const char* a2 = last ? nA : cA + (size_t)(t + 2) * kstep; const char* b2 = last ? nB : cB + (size_t)(t + 2) * kstep;
            const char* a3 = a2 + kstep; const char* b3 = b2 + kstep;
            PG8_LDB(B0, 0, 0); PG8_SCHED; PG8_LDA(At, 0, 0); PG8_STAGE(PG8_SA(1, 1), a1 + hstep, voffA);
            PG8_WAIT_L(8); PG8_BAR; PG8_WAIT_L(0); PG8_MMA(0, 0, At, B0); PG8_BAR; PG8_SCHED;
            PG8_LDB(B1, 0, 1); PG8_STAGE(PG8_SB(0, 0), b2, voffB);
            PG8_BAR; PG8_WAIT_L(0); PG8_MMA(0, 1, At, B1); PG8_BAR;
            PG8_LDA(At, 0, 1); PG8_STAGE(PG8_SA(0, 0), a2, voffA);
            PG8_BAR; PG8_WAIT_L(0); PG8_MMA(1, 0, At, B0); PG8_BAR; PG8_SCHED;
            PG8_STAGE(PG8_SB(0, 1), b2 + hstep, voffB);
            PG8_WAIT_V(6); PG8_BAR; PG8_MMA(1, 1, At, B1); PG8_BAR;
            PG8_LDB(B0, 1, 0); PG8_SCHED; PG8_LDA(At, 1, 0); PG8_STAGE(PG8_SA(0, 1), a2 + hstep, voffA);
            PG8_WAIT_L(8); PG8_BAR; PG8_WAIT_L(0); PG8_MMA(0, 0, At, B0); PG8_BAR; PG8_SCHED;
            PG8_LDB(B1, 1, 1); PG8_STAGE(PG8_SB(1, 0), b3, voffB);
            PG8_BAR; PG8_WAIT_L(0); PG8_MMA(0, 1, At, B1); PG8_BAR;
            PG8_LDA(At, 1, 1); PG8_STAGE(PG8_SA(1, 0), a3, voffA);
            PG8_BAR; PG8_WAIT_L(0); PG8_MMA(1, 0, At, B0); PG8_BAR; PG8_SCHED;
            PG8_STAGE(PG8_SB(1, 1), b3 + hstep, voffB);
            PG8_WAIT_V(6); PG8_BAR; PG8_MMA(1, 1, At, B1); PG8_BAR;
        }
        E(acc, cur, wr, wc, fr, fq);
        if (!has_next) break;
#pragma unroll
        for (int a = 0; a < 2; ++a)
#pragma unroll
            for (int b = 0; b < 2; ++b)
#pragma unroll
                for (int m = 0; m < 4; ++m)
#pragma unroll
                    for (int n = 0; n < 2; ++n) acc[a][b][m][n] = (f32x4){0.f, 0.f, 0.f, 0.f};
        cur = nxt; cA = nA; cB = nB; ++ui;
    }
    PG8_WAIT_V(0);
    if (wr == 0) PG8_BAR;
    PG8_BAR;
#undef PG8_SA
#undef PG8_SB
#undef PG8_STAGE
#undef PG8_LDA
#undef PG8_LDB
#undef PG8_MMA
#undef PG8_WAIT_V
#undef PG8_WAIT_L
#undef PG8_BAR
#undef PG8_SCHED
}
}

struct EpiSwiGLU {
    static constexpr bool PERM = true;
    bf16_t* O;
    __device__ __forceinline__ void operator()(const f32x4 (&acc)[2][2][4][2], const pg8::Unit& u, int wr, int wc, int fr, int fq) const {
        const int row0 = u.pm * 256 + wr * 64 + fr, col0 = u.pn * 128 + wc * 32 + 8 * fq;
#pragma unroll
        for (int ai = 0; ai < 2; ++ai)
#pragma unroll
            for (int m = 0; m < 4; ++m) {
                bf16_t* rowp = O + (size_t)(row0 + ai * 128 + m * 16) * DFF + col0;
                const f32x4 a0 = acc[ai][0][m][0], a1 = acc[ai][0][m][1], b0 = acc[ai][1][m][0], b1 = acc[ai][1][m][1];
                u32x4 w;
                w.x = cvt_pk_bf16(siluf_(a0[0]) * b0[0], siluf_(a0[1]) * b0[1]); w.y = cvt_pk_bf16(siluf_(a0[2]) * b0[2], siluf_(a0[3]) * b0[3]);
                w.z = cvt_pk_bf16(siluf_(a1[0]) * b1[0], siluf_(a1[1]) * b1[1]); w.w = cvt_pk_bf16(siluf_(a1[2]) * b1[2], siluf_(a1[3]) * b1[3]);
                *(u32x4*)rowp = w;
            }
    }
};
template <bool BASE_BF16>
struct EpiResid {
    static constexpr bool PERM = false;
    const void* base; bf16_t* X; const float* gate; float scale; float* part;
    __device__ __forceinline__ void operator()(const f32x4 (&acc)[2][2][4][2], const pg8::Unit& u, int wr, int wc, int fr, int fq) const {
        const int col0 = u.pn * 256 + wc * 32 + 4 * fq;
        if (u.split >= 0) {
            float* pp = part + (size_t)u.split * 128 * D;
#pragma unroll
            for (int m = 0; m < 4; ++m) { const int r = wr * 64 + m * 16 + fr;
#pragma unroll
                for (int bj = 0; bj < 2; ++bj)
#pragma unroll
                    for (int n = 0; n < 2; ++n) *(f32x4*)(pp + (size_t)r * D + col0 + bj * 128 + n * 16) = acc[0][bj][m][n]; }
            return;
        }
        const int row0 = u.pm * 256 + wr * 64 + fr;
        const float* gp = gate + (size_t)(u.pm >> 3) * NMOD;
        f32x4 gv[2][2];
#pragma unroll
        for (int bj = 0; bj < 2; ++bj)
#pragma unroll
            for (int n = 0; n < 2; ++n) gv[bj][n] = *(const f32x4*)(gp + col0 + bj * 128 + n * 16);
#pragma unroll
        for (int bj = 0; bj < 2; ++bj)
#pragma unroll
            for (int n = 0; n < 2; ++n) gv[bj][n] *= scale;
#pragma unroll
        for (int ai = 0; ai < 2; ++ai)
#pragma unroll
            for (int mp = 0; mp < 2; ++mp) {
                f32x4 bv[2][2][2];
#pragma unroll
                for (int mm = 0; mm < 2; ++mm) {
                    const size_t ro = (size_t)(row0 + ai * 128 + (2 * mp + mm) * 16) * D;
#pragma unroll
                    for (int bj = 0; bj < 2; ++bj)
#pragma unroll
                        for (int n = 0; n < 2; ++n) {
                            const size_t o = ro + col0 + bj * 128 + n * 16;
                            if (BASE_BF16) { const u32x2 w = *(const u32x2*)((const bf16_t*)base + o); bv[mm][bj][n] = (f32x4){bf_lo(w.x), bf_hi(w.x), bf_lo(w.y), bf_hi(w.y)}; }
                            else bv[mm][bj][n] = *(const f32x4*)((const float*)base + o);
                        }
                }
#pragma unroll
                for (int mm = 0; mm < 2; ++mm) {
                    const size_t ro = (size_t)(row0 + ai * 128 + (2 * mp + mm) * 16) * D;
#pragma unroll
                    for (int bj = 0; bj < 2; ++bj)
#pragma unroll
                        for (int n = 0; n < 2; ++n) { const f32x4 v = bv[mm][bj][n] + gv[bj][n] * acc[ai][bj][2 * mp + mm][n];
                            *(u32x2*)(X + ro + col0 + bj * 128 + n * 16) = (u32x2){cvt_pk_bf16(v[0], v[1]), cvt_pk_bf16(v[2], v[3])}; }
                }
            }
    }
};
struct EpiWin {
    static constexpr bool PERM = true;
    bf16_t *Q, *Kb, *V, *GT, *U; float* LF; const float* b_in; const float* lbl; float* ncp; float* part;
    __device__ __forceinline__ void operator()(const f32x4 (&acc)[2][2][4][2], const pg8::Unit& u, int wr, int wc, int fr, int fq) const {
        const int row0 = u.pm * 256 + wr * 64 + fr, cl = wc * 32 + 8 * fq;
        if (u.split >= 0) {
            float* pp = part + (size_t)u.split * 128 * DIN + u.pn * 256 + cl;
#pragma unroll
            for (int m = 0; m < 4; ++m) { const int r = wr * 64 + m * 16 + fr;
#pragma unroll
                for (int bj = 0; bj < 2; ++bj)
#pragma unroll
                    for (int n = 0; n < 2; ++n) *(f32x4*)(pp + (size_t)r * DIN + bj * 128 + 4 * n) = acc[0][bj][m][n]; }
            return;
        }
        if (u.pn < 16) {
            const int region = u.pn >> 2;
#pragma unroll
            for (int bj = 0; bj < 2; ++bj) {
                const int colz = u.pn * 256 + bj * 128 + cl, c1k = colz & 1023;
                const f32x4 bi0 = *(const f32x4*)(b_in + colz), bi1 = *(const f32x4*)(b_in + colz + 4);
                float oml[8];
                if (region == 1) {
#pragma unroll
                    for (int e = 0; e < 8; ++e) { const float l0 = lbl[c1k + e], l1 = lbl[1024 + c1k + e]; oml[e] = 1.0f - 1.0f / (1.0f + __expf(l1 - l0)); }
                }
#pragma unroll
                for (int ai = 0; ai < 2; ++ai)
#pragma unroll
                    for (int m = 0; m < 4; ++m) {
                        const size_t row = (size_t)(row0 + ai * 128 + m * 16);
                        float z[8];
#pragma unroll
                        for (int e = 0; e < 4; ++e) { z[e] = acc[ai][bj][m][0][e] + bi0[e]; z[4 + e] = acc[ai][bj][m][1][e] + bi1[e]; }
                        if (region == 1) {
                            float kk[8], lf[8];
#pragma unroll
                            for (int e = 0; e < 8; ++e) { kk[e] = oml[e] * sigmoidf_(-z[e]); lf[e] = __logf(1.0f - kk[e]); }
                            *(f32x4*)(LF + row * DA + c1k) = (f32x4){lf[0], lf[1], lf[2], lf[3]};
                            *(f32x4*)(LF + row * DA + c1k + 4) = (f32x4){lf[4], lf[5], lf[6], lf[7]};
                            u32x4 w; w.x = cvt_pk_bf16(kk[0], kk[1]); w.y = cvt_pk_bf16(kk[2], kk[3]); w.z = cvt_pk_bf16(kk[4], kk[5]); w.w = cvt_pk_bf16(kk[6], kk[7]);
                            *(u32x4*)(Kb + row * DA + c1k) = w;
                        } else {
                            if (region != 2) {
#pragma unroll
                                for (int e = 0; e < 8; ++e) z[e] = siluf_(z[e]);
                            }
                            u32x4 w; w.x = cvt_pk_bf16(z[0], z[1]); w.y = cvt_pk_bf16(z[2], z[3]); w.z = cvt_pk_bf16(z[4], z[5]); w.w = cvt_pk_bf16(z[6], z[7]);
                            *(u32x4*)(Q + (size_t)region * ((size_t)MPAD * DA) + row * DA + c1k) = w;
                        }
                    }
            }
        } else {
            const int cu = (u.pn - 16) * 128 + cl;
            const f32x4 ba0 = *(const f32x4*)(b_in + 4096 + cu), ba1 = *(const f32x4*)(b_in + 4096 + cu + 4);
            const f32x4 bb0 = *(const f32x4*)(b_in + 5120 + cu), bb1 = *(const f32x4*)(b_in + 5120 + cu + 4);
#pragma unroll
            for (int ai = 0; ai < 2; ++ai)
#pragma unroll
                for (int m = 0; m < 4; ++m) {
                    const int row = row0 + ai * 128 + m * 16;
                    float uu[8];
#pragma unroll
                    for (int e = 0; e < 4; ++e) {
                        uu[e] = (acc[ai][0][m][0][e] + ba0[e]) * sigmoidf_(acc[ai][1][m][0][e] + bb0[e]);
                        uu[4 + e] = (acc[ai][0][m][1][e] + ba1[e]) * sigmoidf_(acc[ai][1][m][1][e] + bb1[e]);
                    }
                    u32x4 w; w.x = cvt_pk_bf16(uu[0], uu[1]); w.y = cvt_pk_bf16(uu[2], uu[3]); w.z = cvt_pk_bf16(uu[4], uu[5]); w.w = cvt_pk_bf16(uu[6], uu[7]);
                    *(u32x4*)(U + (size_t)row * DA + cu) = w;
                    const int tt = row & (SEQ - 1);
                    if (tt >= SEQ - 30) { float* tail = ncp + ((size_t)(row >> 11) * 30 + (tt - (SEQ - 30))) * 1024 + cu;
                        *(f32x4*)tail = (f32x4){uu[0], uu[1], uu[2], uu[3]}; *(f32x4*)(tail + 4) = (f32x4){uu[4], uu[5], uu[6], uu[7]}; }
                }
        }
    }
};

#define LDSBAR2() asm volatile("s_waitcnt lgkmcnt(0)\n\ts_barrier" ::: "memory")
__device__ __forceinline__ int src_col(int mode, int n) {
    if (mode == 1) { const int pn = n >> 8, bj = (n >> 7) & 1, r = n & 127; return bj * DFF + pn * 128 + r; }
    if (mode == 2) { if (n < 4096) return n; const int t = (n - 4096) >> 8, bj = (n >> 7) & 1, r = n & 127; return 4096 + bj * 1024 + t * 128 + r; }
    return n;
}
constexpr int CT_UP = (D / 128) * (2 * DFF / 128), CT_DN = (DFF / 128) * (D / 128), CT_IN = (D / 128) * (DIN / 128), CT_OUT = (D / 128) * (D / 128);
constexpr int CT0 = CT_UP, CT1 = CT0 + CT_DN, CT2 = CT1 + CT_UP, CT3 = CT2 + CT_IN, CT4 = CT3 + CT_OUT, CT_ALL = CT4 + CT_DN;
constexpr int CT_EARLY = CT2, CT_MID = CT4;
constexpr int CT_P0 = CT2 - 672, CT_I3 = CT_P0 + 160, CT_I5 = CT_I3 + 128;
struct ConvTile { const float* src; bf16_t* dst; int Ks, Ns, kt, nt, col0; };
__device__ __forceinline__ ConvTile conv_tile_of(const Args& a, int t) {
    ConvTile c; int mode, ntn, tl; unsigned char* ws = a.ws;
    if (t < CT0)      { tl = t;       c.src = a.in[10]; c.dst = (bf16_t*)(ws + WS_WUP1); c.Ks = D;   c.Ns = 2 * DFF; mode = 1; }
    else if (t < CT1) { tl = t - CT0; c.src = a.in[11]; c.dst = (bf16_t*)(ws + WS_WDN1); c.Ks = DFF; c.Ns = D;       mode = 0; }
    else if (t < CT2) { tl = t - CT1; c.src = a.in[20]; c.dst = (bf16_t*)(ws + WS_WUP2); c.Ks = D;   c.Ns = 2 * DFF; mode = 1; }
    else if (t < CT3) { tl = t - CT2; c.src = a.in[12]; c.dst = (bf16_t*)(ws + WS_WIN);  c.Ks = D;   c.Ns = DIN;     mode = 2; }
    else if (t < CT4) { tl = t - CT3; c.src = a.in[19]; c.dst = (bf16_t*)(ws + WS_WOUT); c.Ks = D;   c.Ns = D;       mode = 0; }
    else              { tl = t - CT4; c.src = a.in[21]; c.dst = (bf16_t*)(ws + WS_WDN2); c.Ks = DFF; c.Ns = D;       mode = 0; }
    ntn = c.Ns / 128; c.kt = tl / ntn; c.nt = tl - c.kt * ntn; c.col0 = src_col(mode, c.nt * 128);
    return c;
}
__device__ __forceinline__ void conv_load(const Args& a, int t, int tid, f32x4 (&r)[8]) {
    const ConvTile c = conv_tile_of(a, t);
    const float* base = c.src + (size_t)(c.kt * 128) * c.Ns + c.col0;
#pragma unroll
    for (int i = 0; i < 8; ++i) { const int idx = tid + NTHR * i; const int c4 = (idx & 7) + 8 * ((idx >> 5) & 3), kk = ((idx >> 3) & 3) + 4 * (idx >> 7);
        r[i] = __builtin_nontemporal_load((const f32x4*)(base + (size_t)kk * c.Ns + 4 * c4)); }
}
__device__ __forceinline__ void conv_emit(LAS float* T, const Args& a, int t, int tid, const f32x4 (&r)[8], bool more, int tnext, f32x4 (&rn)[8]) {
    const int w = tid >> 6, lane = tid & 63, nl = lane >> 3, kc = lane & 7;
#pragma unroll
    for (int i = 0; i < 8; ++i) { const int idx = tid + NTHR * i; const int c4 = (idx & 7) + 8 * ((idx >> 5) & 3), kk = ((idx >> 3) & 3) + 4 * (idx >> 7);
        LAS float* p = T + kk * 129 + 4 * c4; p[0] = r[i][0]; p[1] = r[i][1]; p[2] = r[i][2]; p[3] = r[i][3]; }
    LDSBAR2();
    if (more) conv_load(a, tnext, tid, rn);
    const ConvTile c = conv_tile_of(a, t);
#pragma unroll
    for (int np = 0; np < 2; ++np) {
        const int n = 64 * np + 8 * w + nl;
#pragma unroll
        for (int kp = 0; kp < 2; ++kp) {
            const int k = 64 * kp + 8 * kc;
            float v[8];
#pragma unroll
            for (int e = 0; e < 8; ++e) v[e] = T[(k + e) * 129 + n];
            u32x4 o; o.x = cvt_pk_bf16(v[0], v[1]); o.y = cvt_pk_bf16(v[2], v[3]); o.z = cvt_pk_bf16(v[4], v[5]); o.w = cvt_pk_bf16(v[6], v[7]);
            *(u32x4*)(c.dst + (size_t)(c.nt * 128 + n) * c.Ks + c.kt * 128 + k) = o;
        }
    }
    LDSBAR2();
}
__device__ __forceinline__ void convert_range(LAS unsigned char* lds, const Args& a, int t0, int t1, int first, int G, int tid) {
    LAS float* T = (LAS float*)lds;
    if (t0 + first >= t1) return;
    const int n_my = (t1 - t0 - first + G - 1) / G;
    const int tlast = t0 + first + (n_my - 1) * G;
    f32x4 r0[8], r1[8];
    conv_load(a, t0 + first, tid, r0);
    conv_load(a, min(t0 + first + G, tlast), tid, r1);
#pragma unroll 1
    for (int s2 = 0; s2 < n_my; s2 += 2) {
        const int tA = t0 + first + s2 * G;
        conv_emit(T, a, tA, tid, r0, true, min(tA + 2 * G, tlast), r0);
        conv_emit(T, a, min(tA + G, tlast), tid, r1, true, min(tA + 3 * G, tlast), r1);
    }
    __syncthreads();
}

__device__ __forceinline__ bf16x8 silu_pack8v(const f32x4 x0, const f32x4 x1) {
    u32x4 q; q.x = cvt_pk_bf16(siluf_(x0[0]), siluf_(x0[1])); q.y = cvt_pk_bf16(siluf_(x0[2]), siluf_(x0[3])); q.z = cvt_pk_bf16(siluf_(x1[0]), siluf_(x1[1])); q.w = cvt_pk_bf16(siluf_(x1[2]), siluf_(x1[3]));
    return __builtin_bit_cast(bf16x8, q);
}
__device__ __forceinline__ bf16x8 silu_pack8(const float* p) {
    const f32x4 x0 = *(const f32x4*)p, x1 = *(const f32x4*)(p + 4);
    u32x4 q; q.x = cvt_pk_bf16(siluf_(x0[0]), siluf_(x0[1])); q.y = cvt_pk_bf16(siluf_(x0[2]), siluf_(x0[3])); q.z = cvt_pk_bf16(siluf_(x1[0]), siluf_(x1[1])); q.w = cvt_pk_bf16(siluf_(x1[2]), siluf_(x1[3]));
    return __builtin_bit_cast(bf16x8, q);
}
__device__ __forceinline__ void ada_unit(LAS unsigned char* lds, const Args& a, int unit, int tid) {
    constexpr int NC = 72, PITCH = 136;
    LAS bf16_t* Bt = (LAS bf16_t*)lds;
    const float* W = a.in[7]; const float* bada = a.in[8]; const float* cp = a.in[4]; const float* cs = a.in[5];
    float* MOD = (float*)(a.ws + WS_MOD);
    const int w = tid >> 6, lane = tid & 63, fr = lane & 15, fq = lane >> 4;
    const int n0 = unit * NC;
    f32x4 acc[2][5];
#pragma unroll
    for (int mb = 0; mb < 2; ++mb)
#pragma unroll
        for (int nb = 0; nb < 5; ++nb) acc[mb][nb] = (f32x4){0.f, 0.f, 0.f, 0.f};
    const int r0 = 16 * w + fr, r1 = 128 + fr;
    const float* ap0 = (r0 < 4) ? cp + (size_t)r0 * D : cs + (size_t)(r0 - 4) * D;
    const float* ap1 = cs + (size_t)((r1 < 132 ? r1 : 131) - 4) * D;
    const bool has1 = (w == 0);
    constexpr int FP = 76;
    LAS float* F = (LAS float*)(lds + 32768);
    f32x4 r[5];
#pragma unroll
    for (int i = 0; i < 5; ++i) { const int idx = min(tid + NTHR * i, 128 * 18 - 1); const int kk = idx / 18, c4 = idx % 18;
        r[i] = __builtin_nontemporal_load((const f32x4*)(W + (size_t)kk * NMOD + n0 + 4 * c4)); }
    f32x4 xa[4][2], xb[4][2];
#define ADA_LOADA(KC) do { _Pragma("unroll") for (int ks = 0; ks < 4; ++ks) { const int k_ = (KC) + 32 * ks + 8 * fq; \
        xa[ks][0] = *(const f32x4*)(ap0 + k_); xa[ks][1] = *(const f32x4*)(ap0 + k_ + 4); xb[ks][0] = *(const f32x4*)(ap1 + k_); xb[ks][1] = *(const f32x4*)(ap1 + k_ + 4); } } while (0)
    ADA_LOADA(0);
#pragma unroll 1
    for (int kc0 = 0; kc0 < D; kc0 += 128) {
#pragma unroll
        for (int i = 0; i < 5; ++i) { const int idx = tid + NTHR * i; if (idx < 128 * 18) { const int kk = idx / 18, c4 = idx % 18; *(LAS f32x4*)(F + kk * FP + 4 * c4) = r[i]; } }
        LDSBAR2();
        { const int kn = min(kc0 + 128, D - 128);
#pragma unroll
          for (int i = 0; i < 5; ++i) { const int idx = min(tid + NTHR * i, 128 * 18 - 1); const int kk = idx / 18, c4 = idx % 18;
              r[i] = __builtin_nontemporal_load((const f32x4*)(W + (size_t)(kn + kk) * NMOD + n0 + 4 * c4)); } }
#pragma unroll
        for (int q = 0; q < 3; ++q) { const int it = tid + NTHR * q; if (it < 16 * NC) { const int kg = it / NC, n = it - kg * NC;
            float v[8];
#pragma unroll
            for (int e = 0; e < 8; ++e) v[e] = F[(8 * kg + e) * FP + n];
            *(LAS u32x4*)(Bt + n * PITCH + 8 * kg) = (u32x4){cvt_pk_bf16(v[0], v[1]), cvt_pk_bf16(v[2], v[3]), cvt_pk_bf16(v[4], v[5]), cvt_pk_bf16(v[6], v[7])}; } }
        LDSBAR2();
        bf16x8 A0[4], A1[4];
#pragma unroll
        for (int ks = 0; ks < 4; ++ks) {
            A0[ks] = silu_pack8v(xa[ks][0], xa[ks][1]);
            A1[ks] = (bf16x8){0, 0, 0, 0, 0, 0, 0, 0};
            if (has1) { const bf16x8 t1 = silu_pack8v(xb[ks][0], xb[ks][1]); if (fr < 4) A1[ks] = t1; }
        }
        ADA_LOADA(min(kc0 + 128, D - 128));
#pragma unroll
        for (int ks = 0; ks < 4; ++ks) {
#pragma unroll
            for (int nb = 0; nb < 5; ++nb) {
                const bf16x8 B = *(const LAS bf16x8*)(Bt + (16 * nb + fr) * PITCH + 32 * ks + 8 * fq);
                acc[0][nb] = __builtin_amdgcn_mfma_f32_16x16x32_bf16(A0[ks], B, acc[0][nb], 0, 0, 0);
                if (has1) acc[1][nb] = __builtin_amdgcn_mfma_f32_16x16x32_bf16(A1[ks], B, acc[1][nb], 0, 0, 0);
            }
        }
        LDSBAR2();
    }
#undef ADA_LOADA
    __syncthreads();
    float bv[5];
#pragma unroll
    for (int nb = 0; nb < 5; ++nb) { const int cl = 16 * nb + fr; bv[nb] = bada[n0 + (cl < NC ? cl : 0)]; }
#pragma unroll
    for (int mb = 0; mb < 2; ++mb) {
        if (mb == 1 && !has1) continue;
#pragma unroll
        for (int nb = 0; nb < 5; ++nb) {
            const int cl = 16 * nb + fr;
            if (cl < NC) {
#pragma unroll
                for (int j = 0; j < 4; ++j) { const int row = (mb == 0 ? 16 * w : 128) + 4 * fq + j; if (row < 132) MOD[(size_t)row * NMOD + n0 + cl] = acc[mb][nb][j] + bv[nb]; }
            }
        }
    }
}

struct SampleResid { const float* part; int nsplit; int gate_off; float rscale; };
__device__ __forceinline__ void load_row(const Args& a, int row, const void* src_p, bool p_bf16, const void* src_s, bool s_bf16, const SampleResid& sr, int lane, f32x4 (&x)[8]) {
    const bool isp = row < MP; const bool bf = isp ? p_bf16 : s_bf16;
    const size_t ro = (size_t)(isp ? row : row - MP) * D; const void* src = isp ? src_p : src_s;
    if (bf) {
#pragma unroll
        for (int i = 0; i < 8; ++i) { const u32x2 w = *(const u32x2*)((const bf16_t*)src + ro + 256 * i + 4 * lane); x[i] = (f32x4){bf_lo(w.x), bf_hi(w.x), bf_lo(w.y), bf_hi(w.y)}; }
    } else {
#pragma unroll
        for (int i = 0; i < 8; ++i) x[i] = *(const f32x4*)((const float*)src + ro + 256 * i + 4 * lane);
    }
    if (row >= MP && sr.part) {
        const float* gp = (const float*)(a.ws + WS_MOD) + (size_t)modrow_of(row) * NMOD + sr.gate_off;
        bf16_t* Xr = (bf16_t*)(a.ws + WS_X) + (size_t)row * D;
        f32x4 p[8], gv[8];
#pragma unroll
        for (int i = 0; i < 8; ++i) { p[i] = (f32x4){0.f, 0.f, 0.f, 0.f}; gv[i] = *(const f32x4*)(gp + 256 * i + 4 * lane); }
        const float* pr = sr.part + (size_t)(row - MP) * D + 4 * lane;
#pragma unroll 2
        for (int sp = 0; sp < sr.nsplit; ++sp) {
            f32x4 t[8];
#pragma unroll
            for (int i = 0; i < 8; ++i) t[i] = *(const f32x4*)(pr + 256 * i);
#pragma unroll
            for (int i = 0; i < 8; ++i) p[i] += t[i];
            pr += (size_t)128 * D;
        }
#pragma unroll
        for (int i = 0; i < 8; ++i) { x[i] += sr.rscale * gv[i] * p[i]; *(u32x2*)(Xr + 256 * i + 4 * lane) = (u32x2){cvt_pk_bf16(x[i][0], x[i][1]), cvt_pk_bf16(x[i][2], x[i][3])}; }
    }
}
__device__ __forceinline__ float sample_row(LAS float* red, const Args& a, int si, const void* src_s, bool s_bf16, const SampleResid& sr, int wave, int lane, f32x4& x) {
    const int c = 256 * wave + 4 * lane; const int row = MP + si;
    if (s_bf16) { const u32x2 w = *(const u32x2*)((const bf16_t*)src_s + (size_t)si * D + c); x = (f32x4){bf_lo(w.x), bf_hi(w.x), bf_lo(w.y), bf_hi(w.y)}; }
    else x = *(const f32x4*)((const float*)src_s + (size_t)si * D + c);
    if (sr.part) {
        const f32x4 gv = *(const f32x4*)((const float*)(a.ws + WS_MOD) + (size_t)modrow_of(row) * NMOD + sr.gate_off + c);
        const float* pr = sr.part + (size_t)si * D + c;
        f32x4 p = (f32x4){0.f, 0.f, 0.f, 0.f};
#pragma unroll 8
        for (int sp = 0; sp < sr.nsplit; ++sp) p += *(const f32x4*)(pr + (size_t)sp * 128 * D);
        x += sr.rscale * gv * p;
        *(u32x2*)((bf16_t*)(a.ws + WS_X) + (size_t)row * D + c) = (u32x2){cvt_pk_bf16(x[0], x[1]), cvt_pk_bf16(x[2], x[3])};
    }
    float ss = x[0] * x[0] + x[1] * x[1] + x[2] * x[2] + x[3] * x[3];
#pragma unroll
    for (int o = 32; o >= 1; o >>= 1) ss += __shfl_xor(ss, o);
    __syncthreads();
    if (lane == 0) red[wave] = ss;
    __syncthreads();
    float tot = 0.f;
#pragma unroll
    for (int w8 = 0; w8 < 8; ++w8) tot += red[w8];
    return rsqrtf(tot * (1.0f / D) + EPS);
}
__device__ __forceinline__ void rows_phase(const Args& a, const void* src_p, bool p_bf16, const void* src_s, bool s_bf16, const float* g, int sh_off, int sc_off, bool zero_pad, const SampleResid sr, int tid, LAS unsigned char* lds) {
    const float* MOD = (const float*)(a.ws + WS_MOD);
    bf16_t* H = (bf16_t*)(a.ws + WS_H);
    const int lane = tid & 63, gw = blockIdx.x * 8 + (tid >> 6), nw = gridDim.x * 8;
    if (zero_pad) for (int row = MR + gw; row < MPAD; row += nw) {
#pragma unroll
        for (int i = 0; i < 8; ++i) *(u32x2*)(H + (size_t)row * D + 256 * i + 4 * lane) = (u32x2){0u, 0u};
    }
    for (int si = blockIdx.x; si < MS; si += gridDim.x) {
        const int wave = tid >> 6, c = 256 * wave + 4 * lane, row = MP + si;
        f32x4 x;
        const float rstd = sample_row((LAS float*)lds, a, si, src_s, s_bf16, sr, wave, lane, x);
        const float* mp = MOD + (size_t)modrow_of(row) * NMOD;
        const f32x4 gv = *(const f32x4*)(g + c), sc = *(const f32x4*)(mp + sc_off + c), sh = *(const f32x4*)(mp + sh_off + c);
        const f32x4 h = x * rstd * gv * (1.0f + sc) + sh;
        *(u32x2*)(H + (size_t)row * D + c) = (u32x2){cvt_pk_bf16(h[0], h[1]), cvt_pk_bf16(h[2], h[3])};
    }
    for (int row = gw; row < MP; row += nw) {
        bf16_t* hp = H + (size_t)row * D;
        f32x4 x[8]; float ss = 0.f;
        load_row(a, row, src_p, p_bf16, src_s, s_bf16, sr, lane, x);
#pragma unroll
        for (int i = 0; i < 8; ++i) ss += x[i][0] * x[i][0] + x[i][1] * x[i][1] + x[i][2] * x[i][2] + x[i][3] * x[i][3];
#pragma unroll
        for (int o = 32; o >= 1; o >>= 1) ss += __shfl_xor(ss, o);
        const float rstd = rsqrtf(ss * (1.0f / D) + EPS);
        const float* mp = MOD + (size_t)modrow_of(row) * NMOD;
#pragma unroll
        for (int hf = 0; hf < 2; ++hf) {
            f32x4 gv[4], sc[4], sh[4];
#pragma unroll
            for (int i = 0; i < 4; ++i) { const int c = 256 * (4 * hf + i) + 4 * lane; gv[i] = *(const f32x4*)(g + c); sc[i] = *(const f32x4*)(mp + sc_off + c); sh[i] = *(const f32x4*)(mp + sh_off + c); }
#pragma unroll
            for (int i = 0; i < 4; ++i) { const int c = 256 * (4 * hf + i) + 4 * lane;
                const f32x4 h = x[4 * hf + i] * rstd * gv[i] * (1.0f + sc[i]) + sh[i];
                __hip_atomic_store((unsigned long long*)(hp + c), ((unsigned long long)cvt_pk_bf16(h[2], h[3]) << 32) | cvt_pk_bf16(h[0], h[1]), __ATOMIC_RELAXED, __HIP_MEMORY_SCOPE_AGENT); }
        }
    }
}
__device__ __forceinline__ void final_phase(const Args& a, const SampleResid sr, int tid, LAS unsigned char* lds) {
    const bf16_t* X = (const bf16_t*)(a.ws + WS_X); const float* g = a.in[22];
    const int lane = tid & 63, gw = blockIdx.x * 8 + (tid >> 6), nw = gridDim.x * 8;
    for (int si = blockIdx.x; si < MS; si += gridDim.x) {
        const int wave = tid >> 6, c = 256 * wave + 4 * lane;
        f32x4 x;
        const float rstd = sample_row((LAS float*)lds, a, si, X + (size_t)MP * D, true, sr, wave, lane, x);
        __builtin_nontemporal_store(x * rstd * *(const f32x4*)(g + c), (f32x4*)(a.out + OUT_Y + (size_t)(MP + si) * D + c));
    }
    for (int row = gw; row < MP; row += nw) {
        float* yp = a.out + OUT_Y + (size_t)row * D;
        f32x4 x[8]; float ss = 0.f;
        load_row(a, row, X, true, X + (size_t)MP * D, true, sr, lane, x);
#pragma unroll
        for (int i = 0; i < 8; ++i) ss += x[i][0] * x[i][0] + x[i][1] * x[i][1] + x[i][2] * x[i][2] + x[i][3] * x[i][3];
#pragma unroll
        for (int o = 32; o >= 1; o >>= 1) ss += __shfl_xor(ss, o);
        const float rstd = rsqrtf(ss * (1.0f / D) + EPS);
        f32x4 gv[8];
#pragma unroll
        for (int i = 0; i < 8; ++i) gv[i] = *(const f32x4*)(g + 256 * i + 4 * lane);
#pragma unroll
        for (int i = 0; i < 8; ++i) { const int c = 256 * i + 4 * lane; __builtin_nontemporal_store(x[i] * rstd * gv[i], (f32x4*)(yp + c)); }
    }
}

constexpr int HP = 136, SP = 40, OBP = 132;
constexpr int L_QT = 0, L_QE = L_QT + 32 * HP * 2, L_KT = L_QE + 32 * HP * 2, L_KET = L_KT + 32 * HP * 2, L_VT = L_KET + 128 * SP * 2, L_ST = L_VT + 128 * SP * 2,
              L_ATT = L_ST + 128 * HP * 2, L_OB = L_ATT + 32 * SP * 2, L_PART = L_OB + 32 * OBP * 4, L_EB = L_PART + 4 * 128 * 4, L_HEND = L_EB + 128 * 4;
static_assert(L_HEND <= 131072, "hgrn lds");

#define LDSBAR() asm volatile("s_waitcnt lgkmcnt(0)\n\ts_barrier" ::: "memory")

constexpr int A_P = 136;
constexpr int LA_KET = 0, LA_VT = LA_KET + 128 * A_P * 2, LA_PART = LA_VT + 128 * A_P * 2, LA_EB = LA_PART + 4 * 128 * 4;
__device__ __forceinline__ void hgrn_passA(LAS unsigned char* lds, const Args& a, int bh, int j, int tid) {
    const int w = tid >> 6, lane = tid & 63, fr = lane & 15, fq = lane >> 4;
    const int kch = tid & 127, tq = tid >> 7;
    const int b = bh >> 3, h = bh & 7;
    const bf16_t* Kb = (const bf16_t*)(a.ws + WS_K); const bf16_t* Vb = (const bf16_t*)(a.ws + WS_V); const float* LF = (const float*)(a.ws + WS_LF);
    float* LLOC = (float*)(a.ws + WS_LLOC); float* DLOC = (float*)(a.ws + WS_DLOC);
    LAS bf16_t* KET = (LAS bf16_t*)(lds + LA_KET); LAS bf16_t* VT = (LAS bf16_t*)(lds + LA_VT); LAS float* PART = (LAS float*)(lds + LA_PART); LAS float* EB = (LAS float*)(lds + LA_EB);
    f32x4 accS[8];
#pragma unroll
    for (int kb = 0; kb < 8; ++kb) accS[kb] = (f32x4){0.f, 0.f, 0.f, 0.f};
    float btot = 0.f;
    const int row0 = b * SEQ + j * 256;
    const int vs = tid & 31, vc8 = tid >> 5;
#pragma unroll 1
    for (int c = 0; c < 2; ++c) {
        const int rowc = row0 + 128 * c;
        float cs[32], kk[32];
        {   const float* pl = LF + (size_t)(rowc + 32 * tq) * DA + 128 * h + kch; const bf16_t* pk = Kb + (size_t)(rowc + 32 * tq) * DA + 128 * h + kch;
#pragma unroll
            for (int i = 0; i < 32; ++i) { cs[i] = *pl; kk[i] = bf2f(*pk); pl += DA; pk += DA; asm("" : "+v"(pl), "+v"(pk)); } }
        u32x4 v16[4];
        {   const bf16_t* pv = Vb + (size_t)(rowc + vs) * DA + 128 * h + 8 * vc8;
#pragma unroll
            for (int i = 0; i < 4; ++i) { v16[i] = *(const u32x4*)pv; pv += 32 * DA; asm("" : "+v"(pv)); } }
#pragma unroll
        for (int i = 1; i < 32; ++i) cs[i] += cs[i - 1];
        PART[tq * 128 + kch] = cs[31];
#pragma unroll
        for (int i = 0; i < 4; ++i) {
            LAS bf16_t* p = VT + (8 * vc8) * A_P + vs + 32 * i;
            p[0] = (bf16_t)(v16[i].x & 0xffffu); p[A_P] = (bf16_t)(v16[i].x >> 16); p[2 * A_P] = (bf16_t)(v16[i].y & 0xffffu); p[3 * A_P] = (bf16_t)(v16[i].y >> 16);
            p[4 * A_P] = (bf16_t)(v16[i].z & 0xffffu); p[5 * A_P] = (bf16_t)(v16[i].z >> 16); p[6 * A_P] = (bf16_t)(v16[i].w & 0xffffu); p[7 * A_P] = (bf16_t)(v16[i].w >> 16);
        }
        LDSBAR();
        const float p0 = PART[kch], p1 = PART[128 + kch], p2 = PART[256 + kch], p3 = PART[384 + kch];
        const float offs = (tq > 0 ? p0 : 0.f) + (tq > 1 ? p1 : 0.f) + (tq > 2 ? p2 : 0.f);
        const float Bc = (p0 + p1) + (p2 + p3);
#pragma unroll
        for (int g8 = 0; g8 < 4; ++g8) {
            float ke[8];
#pragma unroll
            for (int e = 0; e < 8; ++e) ke[e] = kk[8 * g8 + e] * __expf(Bc - (offs + cs[8 * g8 + e]));
            *(LAS u32x4*)(KET + kch * A_P + 32 * tq + 8 * g8) = (u32x4){cvt_pk_bf16(ke[0], ke[1]), cvt_pk_bf16(ke[2], ke[3]), cvt_pk_bf16(ke[4], ke[5]), cvt_pk_bf16(ke[6], ke[7])};
        }
        if (tq == 0) EB[kch] = __expf(Bc);
        btot += Bc;
        LDSBAR();
#pragma unroll
        for (int kb = 0; kb < 8; ++kb) accS[kb] *= *(const LAS f32x4*)(EB + 16 * kb + 4 * fq);
#pragma unroll
        for (int ks = 0; ks < 4; ++ks) {
            const bf16x8 Bv = *(const LAS bf16x8*)(VT + (16 * w + fr) * A_P + 32 * ks + 8 * fq);
#pragma unroll
            for (int kb = 0; kb < 8; ++kb) {
                const bf16x8 A = *(const LAS bf16x8*)(KET + (16 * kb + fr) * A_P + 32 * ks + 8 * fq);
                accS[kb] = __builtin_amdgcn_mfma_f32_16x16x32_bf16(A, Bv, accS[kb], 0, 0, 0);
            }
        }
        LDSBAR();
    }
    float* Lp = LLOC + (size_t)(bh * 8 + j) * 128 * 128;
#pragma unroll
    for (int kb = 0; kb < 8; ++kb) *(f32x4*)(Lp + ((size_t)(w * 8 + kb) * 64 + lane) * 4) = accS[kb];
    if (tq == 0) DLOC[(size_t)(bh * 8 + j) * 128 + kch] = __expf(btot);
    __syncthreads();
}

#define HB_LOAD(cc, LFv, KKv, QQv, VV, GG) do { const int rc_ = row0 + 32 * (cc); \
    _Pragma("unroll") for (int i = 0; i < 8; ++i) { const size_t off_ = (size_t)(rc_ + 8 * tq + i) * DA + 128 * h + kch; LFv[i] = LF[off_]; KKv[i] = Kb[off_]; QQv[i] = Qb[off_]; } \
    VV = *(const u32x4*)(Vb + (size_t)(rc_ + vs2) * DA + 128 * h + 8 * vc82); GG = *(const u32x4*)(GT + (size_t)(rc_ + vs) * DA + 128 * h + 8 * vc8); } while (0)
__device__ __forceinline__ void hgrn_passB(LAS unsigned char* lds, const Args& a, int bh, int j, int tid) {
    const int w = tid >> 6, lane = tid & 63, fr = lane & 15, fq = lane >> 4;
    const int kch = tid & 127, tq = tid >> 7;
    const int b = bh >> 3, h = bh & 7;
    const bf16_t* Qb = (const bf16_t*)(a.ws + WS_Q); const bf16_t* Kb = (const bf16_t*)(a.ws + WS_K); const bf16_t* Vb = (const bf16_t*)(a.ws + WS_V);
    const bf16_t* GT = (const bf16_t*)(a.ws + WS_GT); const float* LF = (const float*)(a.ws + WS_LF);
    bf16_t* OMIX = (bf16_t*)(a.ws + WS_OMIX);
    const float* LLOC = (const float*)(a.ws + WS_LLOC); const float* DLOC = (const float*)(a.ws + WS_DLOC);
    LAS bf16_t* QT = (LAS bf16_t*)(lds + L_QT); LAS bf16_t* QE = (LAS bf16_t*)(lds + L_QE); LAS bf16_t* KT = (LAS bf16_t*)(lds + L_KT);
    LAS bf16_t* KET = (LAS bf16_t*)(lds + L_KET); LAS bf16_t* VT = (LAS bf16_t*)(lds + L_VT); LAS bf16_t* ST = (LAS bf16_t*)(lds + L_ST);
    LAS bf16_t* ATT = (LAS bf16_t*)(lds + L_ATT); LAS float* OB = (LAS float*)(lds + L_OB); LAS float* PART = (LAS float*)(lds + L_PART); LAS float* EB = (LAS float*)(lds + L_EB);
    const int row0 = b * SEQ + j * 256;
    const int vs = tid >> 4, vc8 = tid & 15;
    const int vs2 = tid & 31, vc82 = tid >> 5;
    float lf_c[8]; bf16_t kk_c[8], q_c[8]; u32x4 v_c, g_c;
    HB_LOAD(0, lf_c, kk_c, q_c, v_c, g_c);
    f32x4 accS[8];
#pragma unroll
    for (int kb = 0; kb < 8; ++kb) accS[kb] = (f32x4){0.f, 0.f, 0.f, 0.f};
    {
        LAS float* DL = OB;
        for (int t = tid; t < j * 128; t += NTHR) DL[t] = DLOC[(size_t)bh * 8 * 128 + t];
        __syncthreads();
        int jj = 0;
        for (; jj + 1 < j; jj += 2) {
            const float* L0 = LLOC + (size_t)(bh * 8 + jj) * 128 * 128 + ((size_t)(w * 8) * 64 + lane) * 4;
            f32x4 l0[8], l1[8];
#pragma unroll
            for (int kb = 0; kb < 8; ++kb) { l0[kb] = *(const f32x4*)(L0 + (size_t)kb * 256); l1[kb] = *(const f32x4*)(L0 + 128 * 128 + (size_t)kb * 256); }
#pragma unroll
            for (int kb = 0; kb < 8; ++kb) { const f32x4 d0 = *(const LAS f32x4*)(DL + jj * 128 + 16 * kb + 4 * fq), d1 = *(const LAS f32x4*)(DL + (jj + 1) * 128 + 16 * kb + 4 * fq);
                accS[kb] = d1 * (d0 * accS[kb] + l0[kb]) + l1[kb]; }
        }
        if (jj < j) {
            const float* L0 = LLOC + (size_t)(bh * 8 + jj) * 128 * 128 + ((size_t)(w * 8) * 64 + lane) * 4;
            f32x4 l0[8];
#pragma unroll
            for (int kb = 0; kb < 8; ++kb) l0[kb] = *(const f32x4*)(L0 + (size_t)kb * 256);
#pragma unroll
            for (int kb = 0; kb < 8; ++kb) { const f32x4 d0 = *(const LAS f32x4*)(DL + jj * 128 + 16 * kb + 4 * fq); accS[kb] = d0 * accS[kb] + l0[kb]; }
        }
    }
    const float* gn = a.in[14] + 128 * h + 8 * vc8;
    const f32x4 gn0 = *(const f32x4*)gn, gn1 = *(const f32x4*)(gn + 4);
#pragma unroll 1
    for (int c = 0; c < 8; ++c) {
        const int rowc = row0 + 32 * c;
        float lf_n[8]; bf16_t kk_n[8], q_n[8]; u32x4 v_n, g_n;
        if (c < 7) HB_LOAD(c + 1, lf_n, kk_n, q_n, v_n, g_n);
        else {
#pragma unroll
            for (int i = 0; i < 8; ++i) { lf_n[i] = 0.f; kk_n[i] = 0; q_n[i] = 0; }
            v_n = (u32x4){0u, 0u, 0u, 0u}; g_n = v_n;
        }
        float cs[8];
#pragma unroll
        for (int i = 0; i < 8; ++i) cs[i] = lf_c[i];
#pragma unroll
        for (int i = 1; i < 8; ++i) cs[i] += cs[i - 1];
        PART[tq * 128 + kch] = cs[7];
        {
            LAS bf16_t* p = VT + (8 * vc82) * SP + vs2;
            p[0] = (bf16_t)(v_c.x & 0xffffu); p[SP] = (bf16_t)(v_c.x >> 16); p[2 * SP] = (bf16_t)(v_c.y & 0xffffu); p[3 * SP] = (bf16_t)(v_c.y >> 16);
            p[4 * SP] = (bf16_t)(v_c.z & 0xffffu); p[5 * SP] = (bf16_t)(v_c.z >> 16); p[6 * SP] = (bf16_t)(v_c.w & 0xffffu); p[7 * SP] = (bf16_t)(v_c.w >> 16);
        }
#pragma unroll
        for (int kb = 0; kb < 8; ++kb)
            *(LAS u32x2*)(ST + (16 * w + fr) * HP + 16 * kb + 4 * fq) = (u32x2){cvt_pk_bf16(accS[kb][0], accS[kb][1]), cvt_pk_bf16(accS[kb][2], accS[kb][3])};
        LDSBAR();
        const float p0 = PART[kch], p1 = PART[128 + kch], p2 = PART[256 + kch], p3 = PART[384 + kch];
        const float offs = (tq > 0 ? p0 : 0.f) + (tq > 1 ? p1 : 0.f) + (tq > 2 ? p2 : 0.f);
        const float mref = p0 + p1, Bc = (p0 + p1) + (p2 + p3);
        float ke[8];
#pragma unroll
        for (int i = 0; i < 8; ++i) {
            const float bb = offs + cs[i], kkf = bf2f(kk_c[i]), qf = bf2f(q_c[i]);
            ke[i] = kkf * __expf(Bc - bb);
            const int t = 8 * tq + i;
            QT[t * HP + kch] = f2bf(qf * __expf(bb - mref));
            QE[t * HP + kch] = f2bf(qf * __expf(bb));
            KT[t * HP + kch] = f2bf(kkf * __expf(mref - bb));
        }
        *(LAS u32x4*)(KET + kch * SP + 8 * tq) = (u32x4){cvt_pk_bf16(ke[0], ke[1]), cvt_pk_bf16(ke[2], ke[3]), cvt_pk_bf16(ke[4], ke[5]), cvt_pk_bf16(ke[6], ke[7])};
        if (tq == 0) EB[kch] = __expf(Bc);
        LDSBAR();
        if (w < 4) {
            const int tb = w >> 1, sb = w & 1;
            f32x4 at = (f32x4){0.f, 0.f, 0.f, 0.f};
#pragma unroll
            for (int ks = 0; ks < 4; ++ks) {
                const bf16x8 A = *(const LAS bf16x8*)(QT + (16 * tb + fr) * HP + 32 * ks + 8 * fq);
                const bf16x8 B = *(const LAS bf16x8*)(KT + (16 * sb + fr) * HP + 32 * ks + 8 * fq);
                at = __builtin_amdgcn_mfma_f32_16x16x32_bf16(A, B, at, 0, 0, 0);
            }
#pragma unroll
            for (int i = 0; i < 4; ++i) { const int t = 16 * tb + 4 * fq + i, s = 16 * sb + fr; ATT[t * SP + s] = (s <= t) ? f2bf(at[i]) : (bf16_t)0; }
        }
        f32x4 ao[2] = {(f32x4){0.f, 0.f, 0.f, 0.f}, (f32x4){0.f, 0.f, 0.f, 0.f}};
#pragma unroll
        for (int ks = 0; ks < 4; ++ks) {
            const bf16x8 B = *(const LAS bf16x8*)(ST + (16 * w + fr) * HP + 32 * ks + 8 * fq);
#pragma unroll
            for (int tb = 0; tb < 2; ++tb) {
                const bf16x8 A = *(const LAS bf16x8*)(QE + (16 * tb + fr) * HP + 32 * ks + 8 * fq);
                ao[tb] = __builtin_amdgcn_mfma_f32_16x16x32_bf16(A, B, ao[tb], 0, 0, 0);
            }
        }
        LDSBAR();
        {
            const bf16x8 Bv = *(const LAS bf16x8*)(VT + (16 * w + fr) * SP + 8 * fq);
#pragma unroll
            for (int tb = 0; tb < 2; ++tb) {
                const bf16x8 A = *(const LAS bf16x8*)(ATT + (16 * tb + fr) * SP + 8 * fq);
                ao[tb] = __builtin_amdgcn_mfma_f32_16x16x32_bf16(A, Bv, ao[tb], 0, 0, 0);
#pragma unroll
                for (int i = 0; i < 4; ++i) OB[(16 * tb + 4 * fq + i) * OBP + 16 * w + fr] = ao[tb][i];
            }
#pragma unroll
            for (int kb = 0; kb < 8; ++kb) {
                const f32x4 eb = *(const LAS f32x4*)(EB + 16 * kb + 4 * fq);
                const bf16x8 A = *(const LAS bf16x8*)(KET + (16 * kb + fr) * SP + 8 * fq);
                accS[kb] = __builtin_amdgcn_mfma_f32_16x16x32_bf16(A, Bv, accS[kb] * eb, 0, 0, 0);
            }
        }
        LDSBAR();
        {
            const f32x4 o0 = *(const LAS f32x4*)(OB + vs * OBP + 8 * vc8), o1 = *(const LAS f32x4*)(OB + vs * OBP + 8 * vc8 + 4);
            float ss = o0[0] * o0[0] + o0[1] * o0[1] + o0[2] * o0[2] + o0[3] * o0[3] + o1[0] * o1[0] + o1[1] * o1[1] + o1[2] * o1[2] + o1[3] * o1[3];
            ss += __shfl_xor(ss, 1); ss += __shfl_xor(ss, 2); ss += __shfl_xor(ss, 4); ss += __shfl_xor(ss, 8);
            const float rstd = rsqrtf(ss * (1.0f / 128.0f) + EPS);
            u32x4 o;
            o.x = cvt_pk_bf16(o0[0] * rstd * gn0[0] * bf_lo(g_c.x), o0[1] * rstd * gn0[1] * bf_hi(g_c.x));
            o.y = cvt_pk_bf16(o0[2] * rstd * gn0[2] * bf_lo(g_c.y), o0[3] * rstd * gn0[3] * bf_hi(g_c.y));
            o.z = cvt_pk_bf16(o1[0] * rstd * gn1[0] * bf_lo(g_c.z), o1[1] * rstd * gn1[1] * bf_hi(g_c.z));
            o.w = cvt_pk_bf16(o1[2] * rstd * gn1[2] * bf_lo(g_c.w), o1[3] * rstd * gn1[3] * bf_hi(g_c.w));
            *(u32x4*)(OMIX + (size_t)(rowc + vs) * D + 128 * h + 8 * vc8) = o;
        }
#pragma unroll
        for (int i = 0; i < 8; ++i) { lf_c[i] = lf_n[i]; kk_c[i] = kk_n[i]; q_c[i] = q_n[i]; }
        v_c = v_n; g_c = g_n;
    }
    if (j == 7) {
        float* Sp = a.out + OUT_HP + (size_t)bh * 128 * 128;
#pragma unroll
        for (int kb = 0; kb < 8; ++kb)
#pragma unroll
            for (int i = 0; i < 4; ++i) Sp[(size_t)(16 * kb + 4 * fq + i) * 128 + 16 * w + fr] = accS[kb][i];
    }
    __syncthreads();
}

template <int NV>
__device__ __forceinline__ void block_reduce(LAS float* red, float (&v)[NV], int tid) {
    const int w = tid >> 6, lane = tid & 63;
#pragma unroll
    for (int i = 0; i < NV; ++i) {
#pragma unroll
        for (int o = 32; o >= 1; o >>= 1) v[i] += __shfl_xor(v[i], o);
    }
    __syncthreads();
    if (lane == 0) {
#pragma unroll
        for (int i = 0; i < NV; ++i) red[w * NV + i] = v[i];
    }
    __syncthreads();
#pragma unroll
    for (int i = 0; i < NV; ++i) { float s = 0.f;
#pragma unroll
        for (int ww = 0; ww < 8; ++ww) s += red[ww * NV + i];
        v[i] = s; }
}
__device__ __forceinline__ void conv_prompt_phase(LAS unsigned char* lds, const Args& a, int tid) {
    constexpr int T = 8;
    const bf16_t* U = (const bf16_t*)(a.ws + WS_U); bf16_t* OMIX = (bf16_t*)(a.ws + WS_OMIX);
    const float* cw = a.in[15]; const float* cb = a.in[16]; const float* lg = a.in[17]; const float* lb = a.in[18];
    const int c = 2 * tid;
    f32x2 wv[CW];
    { const char* pw = (const char*)(cw + c);
#pragma unroll
      for (int jx = 0; jx < CW; ++jx) { wv[jx] = *(const f32x2*)pw; pw += 4096; asm("" : "+v"(pw)); } }
    const f32x2 cbv = *(const f32x2*)(cb + c), lgv = *(const f32x2*)(lg + c), lbv = *(const f32x2*)(lb + c);
    const int vb = (gridDim.x % 8 == 0) ? (int)((blockIdx.x & 7) * (gridDim.x >> 3) + (blockIdx.x >> 3)) : (int)blockIdx.x;
#pragma unroll 1
    for (int unit = vb; unit < NBATCH * (SEQ / T); unit += gridDim.x) {
        const int b = unit / (SEQ / T), t0 = (unit % (SEQ / T)) * T, rbase = b * SEQ;
        f32x2 y[T];
#pragma unroll
        for (int t = 0; t < T; ++t) y[t] = cbv;
        const char* pu = (const char*)(U + ((long)rbase + t0 - 30) * DA + c);
#pragma unroll
        for (int r = 0; r < T + 30; ++r) {
            const int tok = t0 - 30 + r; unsigned x = 0u;
            if (tok >= 0) x = *(const unsigned*)pu;
            pu += DA * 2; asm("" : "+v"(pu));
            const f32x2 xv = (f32x2){bf_lo(x), bf_hi(x)};
#pragma unroll
            for (int t = 0; t < T; ++t) { const int jx = r - t; if (jx >= 0 && jx < CW) y[t] += wv[jx] * xv; }
        }
        float st[2 * T];
#pragma unroll
        for (int t = 0; t < T; ++t) { st[t] = y[t].x + y[t].y; st[T + t] = y[t].x * y[t].x + y[t].y * y[t].y; }
        block_reduce<2 * T>((LAS float*)lds, st, tid);
#pragma unroll
        for (int t = 0; t < T; ++t) {
            const float mean = st[t] * (1.0f / 1024.0f), var = fmaxf(st[T + t] * (1.0f / 1024.0f) - mean * mean, 0.f), rstd = rsqrtf(var + EPS);
            const float z0 = (y[t].x - mean) * rstd * lgv.x + lbv.x, z1 = (y[t].y - mean) * rstd * lgv.y + lbv.y;
            *(unsigned*)(OMIX + (size_t)(rbase + t0 + t) * D + 1024 + c) = cvt_pk_bf16(siluf_(z0), siluf_(z1));
        }
        __syncthreads();
    }
}
__device__ __forceinline__ void conv_sample_unit(LAS unsigned char* lds, const Args& a, int i, int tid) {
    const bf16_t* U = (const bf16_t*)(a.ws + WS_U); bf16_t* OMIX = (bf16_t*)(a.ws + WS_OMIX);
    const float* cw = a.in[15]; const float* cb = a.in[16]; const float* lg = a.in[17]; const float* lb = a.in[18];
    const float* sc = a.in[3] + (size_t)i * 30 * 1024; float* ncs = a.out + OUT_CS + (size_t)i * 30 * 1024;
    const int c = 2 * tid;
    const f32x2 cbv = *(const f32x2*)(cb + c);
    float y0 = cbv.x, y1 = cbv.y;
    const char* ps = (const char*)(sc + c); const char* pw = (const char*)(cw + c); char* pn = (char*)(ncs + c);
    f32x2 sv[30];
#pragma unroll
    for (int r = 0; r < 30; ++r) {
        sv[r] = *(const f32x2*)ps; const f32x2 wv = *(const f32x2*)pw;
        y0 += wv.x * sv[r].x; y1 += wv.y * sv[r].y;
        ps += 4096; pw += 4096; asm("" : "+v"(ps), "+v"(pw));
    }
#pragma unroll
    for (int r = 1; r < 30; ++r) { __builtin_nontemporal_store(sv[r], (f32x2*)pn); pn += 4096; asm("" : "+v"(pn)); }
    {
        const float* P = (const float*)(a.ws + WS_PART); const float* b_in = a.in[13];
        const int na = 4096 + (c >> 7) * 256 + (c & 127);
        f32x2 za = *(const f32x2*)(b_in + 4096 + c), zb = *(const f32x2*)(b_in + 5120 + c);
        f32x2 pa[NS_IN], pb[NS_IN];
#pragma unroll
        for (int sp = 0; sp < NS_IN; ++sp) { const float* pr = P + ((size_t)sp * 128 + i) * DIN + na; pa[sp] = *(const f32x2*)pr; pb[sp] = *(const f32x2*)(pr + 128); }
#pragma unroll
        for (int sp = 0; sp < NS_IN; ++sp) { za += pa[sp]; zb += pb[sp]; }
        const f32x2 uv = (f32x2){za.x * sigmoidf_(zb.x), za.y * sigmoidf_(zb.y)};
        *(f32x2*)(ncs + 29 * 1024 + c) = uv;
        const f32x2 wv = *(const f32x2*)pw; y0 += wv.x * uv.x; y1 += wv.y * uv.y; }
    float st[2] = {y0 + y1, y0 * y0 + y1 * y1};
    block_reduce<2>((LAS float*)lds, st, tid);
    const float mean = st[0] * (1.0f / 1024.0f), var = fmaxf(st[1] * (1.0f / 1024.0f) - mean * mean, 0.f), rstd = rsqrtf(var + EPS);
    const f32x2 lgv = *(const f32x2*)(lg + c), lbv = *(const f32x2*)(lb + c);
    const float z0 = (y0 - mean) * rstd * lgv.x + lbv.x, z1 = (y1 - mean) * rstd * lgv.y + lbv.y;
    *(unsigned*)(OMIX + (size_t)(MP + i) * D + 1024 + c) = cvt_pk_bf16(siluf_(z0), siluf_(z1));
    __syncthreads();
}
__device__ __forceinline__ void hgrn_sample_unit(LAS unsigned char* lds, const Args& a, int unit, int tid) {
    const int i = unit >> 3, h = unit & 7, row = MP + i;
    bf16_t* OMIX = (bf16_t*)(a.ws + WS_OMIX);
    const float* S0 = a.in[2] + (size_t)unit * 128 * 128; float* S1 = a.out + OUT_HS + (size_t)unit * 128 * 128;
    LAS float* RED = (LAS float*)lds;
    LAS float* R2 = (LAS float*)(lds + 8192);
    LAS float* ZQ = (LAS float*)(lds + 8448);
    const int v4 = tid & 31, kr = tid >> 5;
    f32x4 s0v[8];
#pragma unroll
    for (int ii = 0; ii < 8; ++ii) s0v[ii] = __builtin_nontemporal_load((const f32x4*)(S0 + (size_t)(kr + 16 * ii) * 128 + 4 * v4));
    {
        const float* P = (const float*)(a.ws + WS_PART); const float* b_in = a.in[13]; const float* lbl = a.in[6];
        const int which = tid >> 7, k = tid & 127, n = which * 1024 + 128 * h + k;
        float z = b_in[n]; float pz[NS_IN];
#pragma unroll
        for (int sp = 0; sp < NS_IN; ++sp) pz[sp] = P[((size_t)sp * 128 + i) * DIN + n];
#pragma unroll
        for (int sp = 0; sp < NS_IN; ++sp) z += pz[sp];
        if (which == 0) ZQ[k] = siluf_(z);
        else if (which == 1) { const float l0 = lbl[128 * h + k], l1 = lbl[1024 + 128 * h + k]; const float oml = 1.0f - 1.0f / (1.0f + __expf(l1 - l0));
            const float kk = oml * sigmoidf_(-z); ZQ[128 + k] = 1.0f - kk; ZQ[256 + k] = kk; }
        else if (which == 2) ZQ[384 + k] = z;
        else ZQ[512 + k] = siluf_(z);
    }
    __syncthreads();
    const f32x4 vv = *(const LAS f32x4*)(ZQ + 384 + 4 * v4);
    f32x4 acc = (f32x4){0.f, 0.f, 0.f, 0.f};
#pragma unroll
    for (int ii = 0; ii < 8; ++ii) {
        const int k = kr + 16 * ii;
        const float f = ZQ[128 + k], kkv = ZQ[256 + k], qk = ZQ[k];
        const f32x4 s0 = s0v[ii];
        const f32x4 sn = f * s0 + kkv * vv;
        __builtin_nontemporal_store(sn, (f32x4*)(S1 + (size_t)k * 128 + 4 * v4));
        acc += qk * sn;
    }
    *(LAS f32x4*)(RED + kr * 128 + 4 * v4) = acc;
    __syncthreads();
    float o = 0.f;
    if (tid < 128) {
#pragma unroll
        for (int r = 0; r < 16; ++r) o += RED[r * 128 + tid];
        float ss = o * o;
#pragma unroll
        for (int x = 32; x >= 1; x >>= 1) ss += __shfl_xor(ss, x);
        if ((tid & 63) == 0) R2[tid >> 6] = ss;
    }
    __syncthreads();
    if (tid < 128) {
        const float rstd = rsqrtf((R2[0] + R2[1]) * (1.0f / 128.0f) + EPS);
        OMIX[(size_t)row * D + 128 * h + tid] = f2bf(o * rstd * a.in[14][128 * h + tid] * ZQ[512 + tid]);
    }
    __syncthreads();
}


#define XB_TMO      128
#define XB_XCNT(j)  (256  + 64 * (j))
#define XB_XSUB(j)  (1280 + 64 * (j))
#define XB_XGEN(j)  (2304 + 64 * (j))
#define XB_TOP      3328
#define XB_TOPGEN   3392
#define XCD_BAR_WORDS 3456
#define XB_SPIN_CAP (1u << 18)
__device__ __forceinline__ unsigned xb_ld(unsigned* p)              { return __hip_atomic_load(p, __ATOMIC_RELAXED, __HIP_MEMORY_SCOPE_AGENT); }
__device__ __forceinline__ unsigned xb_add(unsigned* p, unsigned v) { return __hip_atomic_fetch_add(p, v, __ATOMIC_RELAXED, __HIP_MEMORY_SCOPE_AGENT); }
__device__ __forceinline__ unsigned xb_xcc_id() { return (unsigned)__builtin_amdgcn_s_getreg((3 << 11) | 20) & 0xFu; }
#define XB_SPIN(cond, bar) do { unsigned _sp = 0; while (cond) { __builtin_amdgcn_s_sleep(1); \
    if ((++_sp & 255u) == 0u) { if (xb_ld(&(bar)[XB_TMO])) break; if (_sp > XB_SPIN_CAP) { atomicAdd(&(bar)[XB_TMO], 1u); break; } } } } while (0)
struct XcdBarrier { unsigned* bar; unsigned x; volatile LAS unsigned* st; };
__device__ __forceinline__ XcdBarrier xcd_barrier_post(unsigned* bar, volatile LAS unsigned* st) {
    XcdBarrier b; b.bar = bar; b.x = xb_xcc_id(); b.st = st;
    if (threadIdx.x == 0) (void)xb_add(&bar[XB_XCNT(b.x)], 1u);
    return b;
}
__device__ __forceinline__ void xcd_barrier_complete(unsigned* bar, unsigned x, unsigned& nloc, unsigned& nx) {
    const unsigned G = gridDim.x * gridDim.y * gridDim.z;
    unsigned sum, cnt, mine, sp = 0u;
    for (;;) {
        sum = 0u; cnt = 0u; mine = 0u;
#pragma unroll
        for (unsigned j = 0; j < 16; ++j) { const unsigned c = xb_ld(&bar[XB_XCNT(j)]); sum += c; cnt += (c > 0u) ? 1u : 0u; mine = (j == x) ? c : mine; }
        if (sum == G) break;
        __builtin_amdgcn_s_sleep(1);
        if ((++sp & 255u) == 0u) { if (xb_ld(&bar[XB_TMO])) break; if (sp > XB_SPIN_CAP) { atomicAdd(&bar[XB_TMO], 1u); break; } }
    }
    nloc = mine > 0u ? mine : 1u; nx = cnt > 0u ? cnt : 1u;
}
__device__ __forceinline__ void xcd_barrier(const XcdBarrier& b) {
    asm volatile("s_waitcnt vmcnt(0)" ::: "memory");
    __syncthreads();
    if (threadIdx.x == 0) {
        unsigned* bar = b.bar;
        __builtin_amdgcn_s_waitcnt(0);
        unsigned nloc = b.st[0], nx = b.st[1];
        if (nloc == 0u) { xcd_barrier_complete(bar, b.x, nloc, nx); b.st[0] = nloc; b.st[1] = nx; }
        const unsigned old = xb_add(&bar[XB_XSUB(b.x)], 1u);
        const unsigned gen = old / nloc;
        if (old + 1u == (gen + 1u) * nloc) {
            __builtin_amdgcn_fence(__ATOMIC_RELEASE, "agent");
            asm volatile("s_waitcnt vmcnt(0)" ::: "memory");
            const unsigned og = xb_add(&bar[XB_TOP], 1u);
            const unsigned tg = og / nx;
            if (og + 1u == (tg + 1u) * nx) xb_add(&bar[XB_TOPGEN], 1u);
            else XB_SPIN(xb_ld(&bar[XB_TOPGEN]) == tg, bar);
            __builtin_amdgcn_fence(__ATOMIC_ACQUIRE, "agent");
            xb_add(&bar[XB_XGEN(b.x)], 1u);
            asm volatile("s_waitcnt vmcnt(0)" ::: "memory");
        } else {
            XB_SPIN(xb_ld(&bar[XB_XGEN(b.x)]) == gen, bar);
            __builtin_amdgcn_fence(__ATOMIC_ACQUIRE, "agent");
            asm volatile("s_waitcnt vmcnt(0)" ::: "memory");
        }
    }
    __syncthreads();
}

#ifndef PHMASK
#define PHMASK 0xFFFF
#endif
#define PH(k) if ((PHMASK >> (k)) & 1)
#ifndef REPMASK
#define REPMASK 0
#endif
#define REP(k)
__global__ void __launch_bounds__(NTHR, 2) hymba_fwd(Args a) {
    extern __shared__ __attribute__((aligned(16))) unsigned char shm[];
    LAS unsigned char* lds = (LAS unsigned char*)shm;
    cg::grid_group grid = cg::this_grid();
    int tid = threadIdx.x; const int bx = blockIdx.x, G = gridDim.x;
#define LAUNDER() asm volatile("" : "+v"(tid))
#define GSYNC() do { xcd_barrier(xb); LAUNDER(); } while (0)
    if (tid < 4) ((LAS unsigned*)(lds + 131072))[tid] = 0u;
    __syncthreads();
    const XcdBarrier xb = xcd_barrier_post((unsigned*)(a.ws + WS_BAR), (volatile LAS unsigned*)(lds + 131072));
    if (a.never) grid.sync();
    unsigned char* ws = a.ws;
    const float* MOD = (const float*)(ws + WS_MOD);
    bf16_t* H = (bf16_t*)(ws + WS_H); bf16_t* Gb = (bf16_t*)(ws + WS_G); bf16_t* X = (bf16_t*)(ws + WS_X); bf16_t* OMIX = (bf16_t*)(ws + WS_OMIX); float* PART = (float*)(ws + WS_PART);

    REP(0) {
    if (!(bx & 1)) { for (int u = bx; u < 256; u += G) ada_unit(lds, a, u, tid); }
    convert_range(lds, a, 0, (G == 256) ? CT_P0 : CT_EARLY, bx, G, tid);
    if (bx & 1) { for (int u = bx; u < 256; u += G) ada_unit(lds, a, u, tid); }
    GSYNC();
    }
    PH(1) rows_phase(a, a.in[0], false, a.in[1], false, a.in[9], 0 * D, 1 * D, true, SampleResid{nullptr, 0, 0, 0.f}, tid, lds);
    GSYNC();
    REP(2) {
    PH(2) { pg8::Gemm g{H, (const bf16_t*)(ws + WS_WUP1), MP, 2 * DFF, D}; pg8::StaticOrder S; S.init(MP, 2 * DFF, D, G, bx, 1); EpiSwiGLU E{Gb};
      pg8::gemm_phase(lds, g, S, E); }
    { int first = bx, stride = G;
      if (G == 256) { first = bx - 172; stride = 84; }
      if (first >= 0) convert_range(lds, a, CT_EARLY, CT_MID, first, stride, tid); }
    GSYNC();
    }
    REP(3) {
    PH(3) { pg8::Gemm g{Gb, (const bf16_t*)(ws + WS_WDN1), MP, D, DFF}; pg8::StaticOrder S; S.init(MP, D, DFF, G, bx, NS_DN); EpiResid<false> E{a.in[0], X, MOD + 2 * D, 0.5f, PART};
      pg8::gemm_phase(lds, g, S, E); }
    if (G == 256 && bx >= NS_DN * 8) convert_range(lds, a, CT_P0, CT_I3, bx - NS_DN * 8, 256 - NS_DN * 8, tid);
    GSYNC();
    }
    PH(4) rows_phase(a, X, true, a.in[1], false, a.in[9] + D, 3 * D, 4 * D, false, SampleResid{PART, NS_DN, 2 * D, 0.5f}, tid, lds);
    GSYNC();
    REP(5) {
    PH(5) { pg8::Gemm g{H, (const bf16_t*)(ws + WS_WIN), MP, DIN, D}; pg8::StaticOrder S; S.init(MP, DIN, D, G, bx, NS_IN);
      EpiWin E{(bf16_t*)(ws + WS_Q), (bf16_t*)(ws + WS_K), (bf16_t*)(ws + WS_V), (bf16_t*)(ws + WS_GT), (bf16_t*)(ws + WS_U), (float*)(ws + WS_LF), a.in[13], a.in[6], a.out + OUT_CP, PART};
      pg8::gemm_phase(lds, g, S, E); }
    if (G == 256 && bx >= NS_IN * 24) convert_range(lds, a, CT_I3, CT_I5, bx - NS_IN * 24, 256 - NS_IN * 24, tid);
    GSYNC();
    }
#define HGRN_SAMPLE_UNITS() do { \
        if (G == 256) { const int nmine_ = bx < 128 ? 3 : 5; for (int k_ = 0; k_ < nmine_; ++k_) { const int u_ = (k_ < 4) ? bx + 256 * k_ : bx - 128 + 768; hgrn_sample_unit(lds, a, u_, tid); } } \
        else { for (int u_ = bx; u_ < MS * NH; u_ += G) hgrn_sample_unit(lds, a, u_, tid); } } while (0)
    REP(6) {
    if (bx & 1) { HGRN_SAMPLE_UNITS(); }
    const int vbx = (G % 8 == 0) ? (bx & 7) * (G >> 3) + (bx >> 3) : bx;
    PH(6) for (int u = vbx; u < 256; u += G) hgrn_passA(lds, a, u >> 3, u & 7, tid);
    PH(14) conv_prompt_phase(lds, a, tid);
    PH(15) for (int u = bx; u < MS; u += G) conv_sample_unit(lds, a, u, tid);
    if (!(bx & 1)) { HGRN_SAMPLE_UNITS(); }
    GSYNC();
    PH(7) for (int u = vbx; u < 256; u += G) hgrn_passB(lds, a, u >> 3, u & 7, tid);
    GSYNC();
    }
    PH(8) { pg8::Gemm g{OMIX, (const bf16_t*)(ws + WS_WOUT), MP, D, D}; pg8::StaticOrder S; S.init(MP, D, D, G, bx, NS_OUT); EpiResid<true> E{X, X, MOD + 5 * D, 1.0f, PART};
      pg8::gemm_phase(lds, g, S, E); }
    if (G == 256 && bx >= NS_OUT * 8) convert_range(lds, a, CT_I5, CT2, bx - NS_OUT * 8, 256 - NS_OUT * 8, tid);
    GSYNC();
    PH(9) rows_phase(a, X, true, X + (size_t)MP * D, true, a.in[9] + 2 * D, 6 * D, 7 * D, false, SampleResid{PART, NS_OUT, 5 * D, 1.0f}, tid, lds);
    GSYNC();
    PH(10) { pg8::Gemm g{H, (const bf16_t*)(ws + WS_WUP2), MP, 2 * DFF, D}; pg8::StaticOrder S; S.init(MP, 2 * DFF, D, G, bx, 1); EpiSwiGLU E{Gb};
      pg8::gemm_phase(lds, g, S, E); }
    { int first = bx, stride = G;
      if (G == 256) { first = bx - 172; stride = 84; }
      if (first >= 0) convert_range(lds, a, CT_MID, CT_ALL, first, stride, tid); }
    GSYNC();
    PH(11) { pg8::Gemm g{Gb, (const bf16_t*)(ws + WS_WDN2), MP, D, DFF}; pg8::StaticOrder S; S.init(MP, D, DFF, G, bx, NS_DN); EpiResid<true> E{X, X, MOD + 8 * D, 0.5f, PART};
      pg8::gemm_phase(lds, g, S, E); }
    GSYNC();
    final_phase(a, SampleResid{PART, NS_DN, 8 * D, 0.5f}, tid, lds);
}

extern "C" void kernel_launch(void* const* d_in, const int* in_sizes, int n_in, void* d_out, int out_size, void* d_ws, size_t ws_size, hipStream_t stream) {
    constexpr int LDS_BYTES = 131072 + 1024;
    static int grid = 0;
    if (!grid) {
        int dev = 0, cus = 0, per_cu = 0;
        (void)hipGetDevice(&dev);
        (void)hipDeviceGetAttribute(&cus, hipDeviceAttributeMultiprocessorCount, dev);
        (void)hipFuncSetAttribute((const void*)hymba_fwd, hipFuncAttributeMaxDynamicSharedMemorySize, LDS_BYTES);
        (void)hipOccupancyMaxActiveBlocksPerMultiprocessor(&per_cu, (const void*)hymba_fwd, NTHR, LDS_BYTES);
        if (ws_size < WS_END || n_in != 23) { fprintf(stderr, "kernel_launch: ws %zu < %zu or n_in %d\n", ws_size, (size_t)WS_END, n_in); grid = -1; return; }
        grid = cus > 0 ? cus : 256;
        fprintf(stderr, "kernel_launch: cus %d per_cu %d grid %d\n", cus, per_cu, grid);
    }
    if (grid < 0) return;
    (void)hipMemsetAsync((unsigned char*)d_ws + WS_BAR, 0, 16384, stream);
    Args a{};
    for (int i = 0; i < 23; ++i) a.in[i] = (const float*)d_in[i];
    a.out = (float*)d_out; a.ws = (unsigned char*)d_ws;
    void* args[] = {&a};
    hipError_t e = hipLaunchCooperativeKernel((const void*)hymba_fwd, dim3(grid), dim3(NTHR), args, LDS_BYTES, stream);
    if (e != hipSuccess) fprintf(stderr, "kernel_launch: cooperative launch failed: %s (grid %d)\n", hipGetErrorString(e), grid);
}
```

```cpp
#include <hip/hip_runtime.h>
#include <hip/hip_cooperative_groups.h>
#include <cstdio>
namespace cg = cooperative_groups;

#define LAS __attribute__((address_space(3)))
typedef unsigned short bf16_t;
typedef short bf16x8 __attribute__((ext_vector_type(8)));
typedef float f32x4 __attribute__((ext_vector_type(4)));
typedef float f32x2 __attribute__((ext_vector_type(2)));
typedef unsigned u32x4 __attribute__((ext_vector_type(4)));
typedef unsigned u32x2 __attribute__((ext_vector_type(2)));

constexpr int D = 2048, NBATCH = 4, SEQ = 2048, MP = NBATCH * SEQ, MS = 128, MR = MP + MS, MPAD = 8448;
constexpr int DFF = 5632, DIN = 6144, DA = 1024, NH = 8, NMOD = 9 * D, CW = 31;
constexpr float EPS = 1e-6f;
constexpr int NTHR = 512;

constexpr size_t SZ_WUP = (size_t)2 * DFF * D * 2, SZ_WDN = (size_t)D * DFF * 2, SZ_WIN = (size_t)DIN * D * 2, SZ_WOUT = (size_t)D * D * 2;
constexpr size_t WS_WUP1 = 0, WS_WDN1 = WS_WUP1 + SZ_WUP, WS_WIN = WS_WDN1 + SZ_WDN, WS_WOUT = WS_WIN + SZ_WIN, WS_WUP2 = WS_WOUT + SZ_WOUT, WS_WDN2 = WS_WUP2 + SZ_WUP;
constexpr size_t WS_MOD = WS_WDN2 + SZ_WDN;
constexpr size_t WS_H = WS_MOD + (size_t)144 * NMOD * 4;
constexpr size_t WS_G = WS_H + (size_t)MPAD * D * 2;
constexpr size_t WS_X = WS_G + (size_t)MPAD * DFF * 2;
constexpr size_t WS_Q = WS_X + (size_t)MPAD * D * 4;
constexpr size_t WS_K = WS_Q + (size_t)MPAD * DA * 2;
constexpr size_t WS_V = WS_K + (size_t)MPAD * DA * 2;
constexpr size_t WS_GT = WS_V + (size_t)MPAD * DA * 2;
constexpr size_t WS_U = WS_GT + (size_t)MPAD * DA * 2;
constexpr size_t WS_LF = WS_U + (size_t)MPAD * DA * 2;
constexpr size_t WS_OMIX = WS_LF + (size_t)MPAD * DA * 4;
constexpr size_t WS_LLOC = WS_OMIX + (size_t)MPAD * D * 2;
constexpr size_t WS_DLOC = WS_LLOC + (size_t)32 * 8 * 128 * 128 * 4;
constexpr size_t WS_PART = WS_DLOC + (size_t)32 * 8 * 128 * 4;
constexpr int NS_DN = 22, NS_IN = 8, NS_OUT = 8;
constexpr size_t WS_BAR = WS_PART + (size_t)8 * 128 * DIN * 4;
constexpr size_t WS_END = WS_BAR + 16384;
static_assert((size_t)NS_DN * 128 * D * 4 <= (size_t)8 * 128 * DIN * 4, "partial buffer");

constexpr size_t OUT_Y = 0, OUT_HP = (size_t)MR * D, OUT_HS = OUT_HP + (size_t)NBATCH * NH * 128 * 128, OUT_CP = OUT_HS + (size_t)MS * NH * 128 * 128,
                 OUT_CS = OUT_CP + (size_t)NBATCH * 30 * 1024;

struct Args {
    const float* in[23];
    float* out;
    unsigned char* ws;
    int never; int pad;
};

typedef __bf16 bf16x2_t __attribute__((ext_vector_type(2)));
__device__ __forceinline__ unsigned cvt_pk_bf16(float lo, float hi) { const f32x2 v = {lo, hi}; const bf16x2_t b = __builtin_convertvector(v, bf16x2_t); return __builtin_bit_cast(unsigned, b); }
__device__ __forceinline__ float bf_lo(unsigned u) { return __uint_as_float(u << 16); }
__device__ __forceinline__ float bf_hi(unsigned u) { return __uint_as_float(u & 0xffff0000u); }
__device__ __forceinline__ float bf2f(bf16_t b) { return __uint_as_float(((unsigned)b) << 16); }
__device__ __forceinline__ bf16_t f2bf(float f) { return (bf16_t)(cvt_pk_bf16(f, 0.f) & 0xffffu); }
__device__ __forceinline__ float sigmoidf_(float x) { return __builtin_amdgcn_rcpf(1.0f + __expf(-x)); }
__device__ __forceinline__ float siluf_(float x) { return x * sigmoidf_(x); }
__device__ __forceinline__ int modrow_of(int row) { return row < MP ? (row >> 11) : (4 + row - MP); }

namespace pg8 {
constexpr int BM = 256, BK = 64, HALF = 128, HTB = HALF * BK * 2, STAGE_BYTES = 8 * HTB, NXCD = 8, WGM = 8;
__device__ __forceinline__ int lds_byte(int r, int c) { const int st = (r >> 4) * 2 + (c >> 5), rr = r & 15, cc = c & 31, ob = rr * 64 + cc * 2; return st * 1024 + (ob ^ (((ob >> 9) & 1) << 5)); }
__device__ __forceinline__ void stage_rc(int b, int& R, int& C) { const int st = b / 1024, sb = b % 1024, swz = sb ^ (((sb >> 9) & 1) << 5); R = (st >> 1) * 16 + swz / 64; C = (st & 1) * 32 + (swz % 64) / 2; }
__device__ __forceinline__ int perm32(int rho) { const int n = rho >> 4, i = rho & 15; return 8 * (i >> 2) + 4 * n + (i & 3); }

struct Unit { int pm, pn, kt0, nt, split; };
struct Gemm { const bf16_t* A; const bf16_t* Bt; int M, N, K; };

struct StaticOrder {
    int nM, nN, nwg, G, c, nt_full, nextra, nNx, ntx, nsplit;
    __device__ void init(int M, int N, int K, int G_, int c_, int nsplit_) { nM = M / BM; nN = N / BM; nwg = nM * nN; G = G_; c = c_; nt_full = K / BK; nNx = nN; nsplit = nsplit_; nextra = nNx * nsplit; ntx = nt_full / nsplit; }
    __device__ bool next(int i, Unit& u) const {
        const long L = (long)i * G + c;
        if (L >= nwg) { const int e = (int)(L - nwg); if (e >= nextra) return false; const int sp = e / nNx; u.pm = 32; u.pn = e - sp * nNx; u.kt0 = sp * ntx; u.nt = ntx; u.split = nsplit > 1 ? sp : -1; return true; }
        int wgid = (int)L; { const int q = nwg / NXCD, r = nwg % NXCD, xcd = wgid % NXCD, off = wgid / NXCD; wgid = (xcd < r ? xcd * (q + 1) : r * (q + 1) + (xcd - r) * q) + off; }
        const int nig = WGM * nN, gid = wgid / nig, fm = gid * WGM, gsz = (nM - fm) < WGM ? (nM - fm) : WGM;
        u.pm = fm + ((wgid % nig) % gsz); u.pn = (wgid % nig) / gsz; u.kt0 = 0; u.nt = nt_full; u.split = -1; return true;
    }
};

template <class Epi, class Sched>
__device__ __forceinline__ void gemm_phase(LAS unsigned char* lds, const Gemm g, const Sched& S, const Epi& E) {
    int tid = threadIdx.x; asm volatile("" : "+v"(tid));
    const int wid = __builtin_amdgcn_readfirstlane(tid >> 6), lane = tid & 63, wr = wid >> 2, wc = wid & 3, fr = lane & 15, fq = lane >> 4;
    const int K = g.K;
    unsigned voffA[2], voffB[2];
#pragma unroll
    for (int i = 0; i < 2; ++i) { int R, C; stage_rc(tid * 16 + i * 8192, R, C); const int Rb = Epi::PERM ? ((R & ~31) + perm32(R & 31)) : R;
        voffA[i] = (unsigned)(R * K + C) * 2u; voffB[i] = (unsigned)(Rb * K + C) * 2u; }
    const size_t kstep = (size_t)(BK * 2);
    const size_t hstep = (size_t)HALF * K * 2;
    const size_t tstep = 2 * hstep;
    const unsigned ldsw = (unsigned)wid * 1024u;
    const int aoff = lds_byte(wr * 64 + fr, fq * 8), boff = lds_byte(wc * 32 + fr, fq * 8);
#define PG8_SA(b, h) (((b) * 2 + (h)) * HTB)
#define PG8_SB(b, h) ((4 + (b) * 2 + (h)) * HTB)
#define PG8_STAGE(bufoff, gbase, voff) do { _Pragma("unroll") for (int _i = 0; _i < 2; ++_i) \
        __builtin_amdgcn_global_load_lds((const unsigned*)((const char*)(gbase) + (voff)[_i]), (LAS unsigned*)(lds + (bufoff) + ldsw + _i * 8192), 16, 0, 0); } while (0)
#define PG8_LDA(dst, b, h) do { _Pragma("unroll") for (int m = 0; m < 4; ++m) _Pragma("unroll") for (int k = 0; k < 2; ++k) dst[m][k] = *(const LAS bf16x8*)(lds + PG8_SA(b, h) + aoff + m * 2048 + k * 1024); } while (0)
#define PG8_LDB(dst, b, h) do { _Pragma("unroll") for (int n = 0; n < 2; ++n) _Pragma("unroll") for (int k = 0; k < 2; ++k) dst[n][k] = *(const LAS bf16x8*)(lds + PG8_SB(b, h) + boff + n * 2048 + k * 1024); } while (0)
#define PG8_MMA(ai, bj, At, Bt) do { __builtin_amdgcn_s_setprio(1); _Pragma("unroll") for (int m = 0; m < 4; ++m) _Pragma("unroll") for (int n = 0; n < 2; ++n) _Pragma("unroll") for (int k = 0; k < 2; ++k) \
        acc[ai][bj][m][n] = __builtin_amdgcn_mfma_f32_16x16x32_bf16(Bt[n][k], At[m][k], acc[ai][bj][m][n], 0, 0, 0); __builtin_amdgcn_s_setprio(0); } while (0)
#define PG8_WAIT_V(n) asm volatile("s_waitcnt vmcnt(" #n ")" ::: "memory")
#define PG8_WAIT_L(n) asm volatile("s_waitcnt lgkmcnt(" #n ")" ::: "memory")
#define PG8_BAR __builtin_amdgcn_s_barrier()
#define PG8_SCHED __builtin_amdgcn_sched_barrier(0)
    Unit cur, nxt; int ui = 0;
    if (!S.next(0, cur)) return;
    f32x4 acc[2][2][4][2];
#pragma unroll
    for (int a = 0; a < 2; ++a)
#pragma unroll
        for (int b = 0; b < 2; ++b)
#pragma unroll
            for (int m = 0; m < 4; ++m)
#pragma unroll
                for (int n = 0; n < 2; ++n) acc[a][b][m][n] = (f32x4){0.f, 0.f, 0.f, 0.f};
    bf16x8 At[4][2], B0[2][2], B1[2][2];
    const char* cA = (const char*)g.A + (size_t)cur.pm * tstep + (size_t)cur.kt0 * kstep; const char* cB = (const char*)g.Bt + (size_t)cur.pn * tstep + (size_t)cur.kt0 * kstep;
    PG8_STAGE(PG8_SB(0, 0), cB, voffB); PG8_STAGE(PG8_SA(0, 0), cA, voffA); PG8_STAGE(PG8_SB(0, 1), cB + hstep, voffB); PG8_STAGE(PG8_SA(0, 1), cA + hstep, voffA);
    if (wr == 1) PG8_BAR;
    PG8_WAIT_V(4); PG8_BAR;
    PG8_STAGE(PG8_SB(1, 0), cB + kstep, voffB); PG8_STAGE(PG8_SA(1, 0), cA + kstep, voffA); PG8_STAGE(PG8_SB(1, 1), cB + hstep + kstep, voffB);
    PG8_WAIT_V(6); PG8_BAR;
    for (;;) {
        const bool has_next = S.next(ui + 1, nxt);
        const char* nA = has_next ? (const char*)g.A + (size_t)nxt.pm * tstep + (size_t)nxt.kt0 * kstep : cA; const char* nB = has_next ? (const char*)g.Bt + (size_t)nxt.pn * tstep + (size_t)nxt.kt0 * kstep : cB;
        const int nt = cur.nt;
        for (int t = 0; t < nt; t += 2) {
            const bool last = (t == nt - 2);
            const char* a1 = cA + (size_t)(t + 1) * kstep;
            const char* a2 = last ? nA : cA + (size_t)(t + 2) * kstep; const char* b2 = last ? nB : cB + (size_t)(t + 2) * kstep;
            const char* a3 = a2 + kstep; const char* b3 = b2 + kstep;
            PG8_LDB(B0, 0, 0); PG8_SCHED; PG8_LDA(At, 0, 0); PG8_STAGE(PG8_SA(1, 1), a1 + hstep, voffA);
            PG8_WAIT_L(8); PG8_BAR; PG8_WAIT_L(0); PG8_MMA(0, 0, At, B0); PG8_BAR; PG8_SCHED;
            PG8_LDB(B1, 0, 1); PG8_STAGE(PG8_SB(0, 0), b2, voffB);
            PG8_BAR; PG8_WAIT_L(0); PG8_MMA(0, 1, At, B1); PG8_BAR;
            PG8_LDA(At, 0, 1); PG8_STAGE(PG8_SA(0, 0), a2, voffA);
            PG8_BAR; PG8_WAIT_L(0); PG8_MMA(1, 0, At, B0); PG8_BAR; PG8_SCHED;
            PG8_STAGE(PG8_SB(0, 1), b2 + hstep, voffB);
            PG8_WAIT_V(6); PG8_BAR; PG8_MMA(1, 1, At, B1); PG8_BAR;
            PG8_LDB(B0, 1, 0); PG8_SCHED; PG8_LDA(At, 1, 0); PG8_STAGE(PG8_SA(0, 1), a2 + hstep, voffA);
            PG8_WAIT_L(8); PG8_BAR; PG8_WAIT_L(0); PG8_MMA(0, 0, At, B0); PG8_BAR; PG8_SCHED;
            PG8_LDB(B1, 1, 1); PG8_STAGE(PG8_SB(1, 0), b3, voffB);
            PG8_BAR; PG8_WAIT_L(0); PG8_MMA(0, 1, At, B1); PG8_BAR;
            PG8_LDA(At, 1, 1); PG8_STAGE(PG8_SA(1, 0), a3, voffA);
            PG8_BAR; PG8_WAIT_L(0); PG8_MMA(1, 0, At, B0); PG8_BAR; PG8_SCHED;
            PG8_STAGE(PG8_SB(1, 1), b3 + hstep, voffB);
            PG8_WAIT_V(6); PG8_BAR; PG8_MMA(1, 1, At, B1); PG8_BAR;
        }
        E(acc, cur, wr, wc, fr, fq);
        if (!has_next) break;
#pragma unroll
        for (int a = 0; a < 2; ++a)
#pragma unroll
            for (int b = 0; b < 2; ++b)
#pragma unroll
                for (int m = 0; m < 4; ++m)
#pragma unroll
                    for (int n = 0; n < 2; ++n) acc[a][b][m][n] = (f32x4){0.f, 0.f, 0.f, 0.f};
        cur = nxt; cA = nA; cB = nB; ++ui;
    }
    PG8_WAIT_V(0);
    if (wr == 0) PG8_BAR;
    PG8_BAR;
#undef PG8_SA
#undef PG8_SB
#undef PG8_STAGE
#undef PG8_LDA
#undef PG8_LDB
#undef PG8_MMA
#undef PG8_WAIT_V
#undef PG8_WAIT_L
#undef PG8_BAR
#undef PG8_SCHED
}
}

struct EpiSwiGLU {
    static constexpr bool PERM = true;
    bf16_t* O;
    __device__ __forceinline__ void operator()(const f32x4 (&acc)[2][2][4][2], const pg8::Unit& u, int wr, int wc, int fr, int fq) const {
        const int row0 = u.pm * 256 + wr * 64 + fr, col0 = u.pn * 128 + wc * 32 + 8 * fq;
#pragma unroll
        for (int ai = 0; ai < 2; ++ai)
#pragma unroll
            for (int m = 0; m < 4; ++m) {
                bf16_t* rowp = O + (size_t)(row0 + ai * 128 + m * 16) * DFF + col0;
                const f32x4 a0 = acc[ai][0][m][0], a1 = acc[ai][0][m][1], b0 = acc[ai][1][m][0], b1 = acc[ai][1][m][1];
                u32x4 w;
                w.x = cvt_pk_bf16(siluf_(a0[0]) * b0[0], siluf_(a0[1]) * b0[1]); w.y = cvt_pk_bf16(siluf_(a0[2]) * b0[2], siluf_(a0[3]) * b0[3]);
                w.z = cvt_pk_bf16(siluf_(a1[0]) * b1[0], siluf_(a1[1]) * b1[1]); w.w = cvt_pk_bf16(siluf_(a1[2]) * b1[2], siluf_(a1[3]) * b1[3]);
                *(u32x4*)rowp = w;
            }
    }
};
template <bool BASE_BF16>
struct EpiResid {
    static constexpr bool PERM = false;
    const void* base; bf16_t* X; const float* gate; float scale; float* part;
    __device__ __forceinline__ void operator()(const f32x4 (&acc)[2][2][4][2], const pg8::Unit& u, int wr, int wc, int fr, int fq) const {
        const int col0 = u.pn * 256 + wc * 32 + 4 * fq;
        if (u.split >= 0) {
            float* pp = part + (size_t)u.split * 128 * D;
#pragma unroll
            for (int m = 0; m < 4; ++m) { const int r = wr * 64 + m * 16 + fr;
#pragma unroll
                for (int bj = 0; bj < 2; ++bj)
#pragma unroll
                    for (int n = 0; n < 2; ++n) *(f32x4*)(pp + (size_t)r * D + col0 + bj * 128 + n * 16) = acc[0][bj][m][n]; }
            return;
        }
        const int row0 = u.pm * 256 + wr * 64 + fr;
        const float* gp = gate + (size_t)(u.pm >> 3) * NMOD;
        f32x4 gv[2][2];
#pragma unroll
        for (int bj = 0; bj < 2; ++bj)
#pragma unroll
            for (int n = 0; n < 2; ++n) gv[bj][n] = *(const f32x4*)(gp + col0 + bj * 128 + n * 16);
#pragma unroll
        for (int bj = 0; bj < 2; ++bj)
#pragma unroll
            for (int n = 0; n < 2; ++n) gv[bj][n] *= scale;
#pragma unroll
        for (int ai = 0; ai < 2; ++ai)
#pragma unroll
            for (int mp = 0; mp < 2; ++mp) {
                f32x4 bv[2][2][2];
#pragma unroll
                for (int mm = 0; mm < 2; ++mm) {
                    const size_t ro = (size_t)(row0 + ai * 128 + (2 * mp + mm) * 16) * D;
#pragma unroll
                    for (int bj = 0; bj < 2; ++bj)
#pragma unroll
                        for (int n = 0; n < 2; ++n) {
                            const size_t o = ro + col0 + bj * 128 + n * 16;
                            if (BASE_BF16) { const u32x2 w = *(const u32x2*)((const bf16_t*)base + o); bv[mm][bj][n] = (f32x4){bf_lo(w.x), bf_hi(w.x), bf_lo(w.y), bf_hi(w.y)}; }
                            else bv[mm][bj][n] = *(const f32x4*)((const float*)base + o);
                        }
                }
#pragma unroll
                for (int mm = 0; mm < 2; ++mm) {
                    const size_t ro = (size_t)(row0 + ai * 128 + (2 * mp + mm) * 16) * D;
#pragma unroll
                    for (int bj = 0; bj < 2; ++bj)
#pragma unroll
                        for (int n = 0; n < 2; ++n) { const f32x4 v = bv[mm][bj][n] + gv[bj][n] * acc[ai][bj][2 * mp + mm][n];
                            *(u32x2*)(X + ro + col0 + bj * 128 + n * 16) = (u32x2){cvt_pk_bf16(v[0], v[1]), cvt_pk_bf16(v[2], v[3])}; }
                }
            }
    }
};
struct EpiWin {
    static constexpr bool PERM = true;
    bf16_t *Q, *Kb, *V, *GT, *U; float* LF; const float* b_in; const float* lbl; float* ncp; float* part;
    __device__ __forceinline__ void operator()(const f32x4 (&acc)[2][2][4][2], const pg8::Unit& u, int wr, int wc, int fr, int fq) const {
        const int row0 = u.pm * 256 + wr * 64 + fr, cl = wc * 32 + 8 * fq;
        if (u.split >= 0) {
            float* pp = part + (size_t)u.split * 128 * DIN + u.pn * 256 + cl;
#pragma unroll
            for (int m = 0; m < 4; ++m) { const int r = wr * 64 + m * 16 + fr;
#pragma unroll
                for (int bj = 0; bj < 2; ++bj)
#pragma unroll
                    for (int n = 0; n < 2; ++n) *(f32x4*)(pp + (size_t)r * DIN + bj * 128 + 4 * n) = acc[0][bj][m][n]; }
            return;
        }
        if (u.pn < 16) {
            const int region = u.pn >> 2;
#pragma unroll
            for (int bj = 0; bj < 2; ++bj) {
                const int colz = u.pn * 256 + bj * 128 + cl, c1k = colz & 1023;
                const f32x4 bi0 = *(const f32x4*)(b_in + colz), bi1 = *(const f32x4*)(b_in + colz + 4);
                float oml[8];
                if (region == 1) {
#pragma unroll
                    for (int e = 0; e < 8; ++e) { const float l0 = lbl[c1k + e], l1 = lbl[1024 + c1k + e]; oml[e] = 1.0f - 1.0f / (1.0f + __expf(l1 - l0)); }
                }
#pragma unroll
                for (int ai = 0; ai < 2; ++ai)
#pragma unroll
                    for (int m = 0; m < 4; ++m) {
                        const size_t row = (size_t)(row0 + ai * 128 + m * 16);
                        float z[8];
#pragma unroll
                        for (int e = 0; e < 4; ++e) { z[e] = acc[ai][bj][m][0][e] + bi0[e]; z[4 + e] = acc[ai][bj][m][1][e] + bi1[e]; }
                        if (region == 1) {
                            float kk[8], lf[8];
#pragma unroll
                            for (int e = 0; e < 8; ++e) { kk[e] = oml[e] * sigmoidf_(-z[e]); lf[e] = __logf(1.0f - kk[e]); }
                            *(f32x4*)(LF + row * DA + c1k) = (f32x4){lf[0], lf[1], lf[2], lf[3]};
                            *(f32x4*)(LF + row * DA + c1k + 4) = (f32x4){lf[4], lf[5], lf[6], lf[7]};
                            u32x4 w; w.x = cvt_pk_bf16(kk[0], kk[1]); w.y = cvt_pk_bf16(kk[2], kk[3]); w.z = cvt_pk_bf16(kk[4], kk[5]); w.w = cvt_pk_bf16(kk[6], kk[7]);
                            *(u32x4*)(Kb + row * DA + c1k) = w;
                        } else {
                            if (region != 2) {
#pragma unroll
                                for (int e = 0; e < 8; ++e) z[e] = siluf_(z[e]);
                            }
                            u32x4 w; w.x = cvt_pk_bf16(z[0], z[1]); w.y = cvt_pk_bf16(z[2], z[3]); w.z = cvt_pk_bf16(z[4], z[5]); w.w = cvt_pk_bf16(z[6], z[7]);
                            *(u32x4*)(Q + (size_t)region * ((size_t)MPAD * DA) + row * DA + c1k) = w;
                        }
                    }
            }
        } else {
            const int cu = (u.pn - 16) * 128 + cl;
            const f32x4 ba0 = *(const f32x4*)(b_in + 4096 + cu), ba1 = *(const f32x4*)(b_in + 4096 + cu + 4);
            const f32x4 bb0 = *(const f32x4*)(b_in + 5120 + cu), bb1 = *(const f32x4*)(b_in + 5120 + cu + 4);
#pragma unroll
            for (int ai = 0; ai < 2; ++ai)
#pragma unroll
                for (int m = 0; m < 4; ++m) {
                    const int row = row0 + ai * 128 + m * 16;
                    float uu[8];
#pragma unroll
                    for (int e = 0; e < 4; ++e) {
                        uu[e] = (acc[ai][0][m][0][e] + ba0[e]) * sigmoidf_(acc[ai][1][m][0][e] + bb0[e]);
                        uu[4 + e] = (acc[ai][0][m][1][e] + ba1[e]) * sigmoidf_(acc[ai][1][m][1][e] + bb1[e]);
                    }
                    u32x4 w; w.x = cvt_pk_bf16(uu[0], uu[1]); w.y = cvt_pk_bf16(uu[2], uu[3]); w.z = cvt_pk_bf16(uu[4], uu[5]); w.w = cvt_pk_bf16(uu[6], uu[7]);
                    *(u32x4*)(U + (size_t)row * DA + cu) = w;
                    const int tt = row & (SEQ - 1);
                    if (tt >= SEQ - 30) { float* tail = ncp + ((size_t)(row >> 11) * 30 + (tt - (SEQ - 30))) * 1024 + cu;
                        *(f32x4*)tail = (f32x4){uu[0], uu[1], uu[2], uu[3]}; *(f32x4*)(tail + 4) = (f32x4){uu[4], uu[5], uu[6], uu[7]}; }
                }
        }
    }
};

#define LDSBAR2() asm volatile("s_waitcnt lgkmcnt(0)\n\ts_barrier" ::: "memory")
__device__ __forceinline__ int src_col(int mode, int n) {
    if (mode == 1) { const int pn = n >> 8, bj = (n >> 7) & 1, r = n & 127; return bj * DFF + pn * 128 + r; }
    if (mode == 2) { if (n < 4096) return n; const int t = (n - 4096) >> 8, bj = (n >> 7) & 1, r = n & 127; return 4096 + bj * 1024 + t * 128 + r; }
    return n;
}
constexpr int CT_UP = (D / 128) * (2 * DFF / 128), CT_DN = (DFF / 128) * (D / 128), CT_IN = (D / 128) * (DIN / 128), CT_OUT = (D / 128) * (D / 128);
constexpr int CT0 = CT_UP, CT1 = CT0 + CT_DN, CT2 = CT1 + CT_UP, CT3 = CT2 + CT_IN, CT4 = CT3 + CT_OUT, CT_ALL = CT4 + CT_DN;
constexpr int CT_EARLY = CT2, CT_MID = CT4;
constexpr int CT_P0 = CT2 - 672, CT_I3 = CT_P0 + 160, CT_I5 = CT_I3 + 128;
struct ConvTile { const float* src; bf16_t* dst; int Ks, Ns, kt, nt, col0; };
__device__ __forceinline__ ConvTile conv_tile_of(const Args& a, int t) {
    ConvTile c; int mode, ntn, tl; unsigned char* ws = a.ws;
    if (t < CT0)      { tl = t;       c.src = a.in[10]; c.dst = (bf16_t*)(ws + WS_WUP1); c.Ks = D;   c.Ns = 2 * DFF; mode = 1; }
    else if (t < CT1) { tl = t - CT0; c.src = a.in[11]; c.dst = (bf16_t*)(ws + WS_WDN1); c.Ks = DFF; c.Ns = D;       mode = 0; }
    else if (t < CT2) { tl = t - CT1; c.src = a.in[20]; c.dst = (bf16_t*)(ws + WS_WUP2); c.Ks = D;   c.Ns = 2 * DFF; mode = 1; }
    else if (t < CT3) { tl = t - CT2; c.src = a.in[12]; c.dst = (bf16_t*)(ws + WS_WIN);  c.Ks = D;   c.Ns = DIN;     mode = 2; }
    else if (t < CT4) { tl = t - CT3; c.src = a.in[19]; c.dst = (bf16_t*)(ws + WS_WOUT); c.Ks = D;   c.Ns = D;       mode = 0; }
    else              { tl = t - CT4; c.src = a.in[21]; c.dst = (bf16_t*)(ws + WS_WDN2); c.Ks = DFF; c.Ns = D;       mode = 0; }
    ntn = c.Ns / 128; c.kt = tl / ntn; c.nt = tl - c.kt * ntn; c.col0 = src_col(mode, c.nt * 128);
    return c;
}
__device__ __forceinline__ void conv_load(const Args& a, int t, int tid, f32x4 (&r)[8]) {
    const ConvTile c = conv_tile_of(a, t);
    const float* base = c.src + (size_t)(c.kt * 128) * c.Ns + c.col0;
#pragma unroll
    for (int i = 0; i < 8; ++i) { const int idx = tid + NTHR * i; const int c4 = (idx & 7) + 8 * ((idx >> 5) & 3), kk = ((idx >> 3) & 3) + 4 * (idx >> 7);
        r[i] = __builtin_nontemporal_load((const f32x4*)(base + (size_t)kk * c.Ns + 4 * c4)); }
}
__device__ __forceinline__ void conv_emit(LAS float* T, const Args& a, int t, int tid, const f32x4 (&r)[8], bool more, int tnext, f32x4 (&rn)[8]) {
    const int w = tid >> 6, lane = tid & 63, nl = lane >> 3, kc = lane & 7;
#pragma unroll
    for (int i = 0; i < 8; ++i) { const int idx = tid + NTHR * i; const int c4 = (idx & 7) + 8 * ((idx >> 5) & 3), kk = ((idx >> 3) & 3) + 4 * (idx >> 7);
        LAS float* p = T + kk * 129 + 4 * c4; p[0] = r[i][0]; p[1] = r[i][1]; p[2] = r[i][2]; p[3] = r[i][3]; }
    LDSBAR2();
    if (more) conv_load(a, tnext, tid, rn);
    const ConvTile c = conv_tile_of(a, t);
#pragma unroll
    for (int np = 0; np < 2; ++np) {
        const int n = 64 * np + 8 * w + nl;
#pragma unroll
        for (int kp = 0; kp < 2; ++kp) {
            const int k = 64 * kp + 8 * kc;
            float v[8];
#pragma unroll
            for (int e = 0; e < 8; ++e) v[e] = T[(k + e) * 129 + n];
            u32x4 o; o.x = cvt_pk_bf16(v[0], v[1]); o.y = cvt_pk_bf16(v[2], v[3]); o.z = cvt_pk_bf16(v[4], v[5]); o.w = cvt_pk_bf16(v[6], v[7]);
            *(u32x4*)(c.dst + (size_t)(c.nt * 128 + n) * c.Ks + c.kt * 128 + k) = o;
        }
    }
    LDSBAR2();
}
__device__ __forceinline__ void convert_range(LAS unsigned char* lds, const Args& a, int t0, int t1, int first, int G, int tid) {
    LAS float* T = (LAS float*)lds;
    if (t0 + first >= t1) return;
    const int n_my = (t1 - t0 - first + G - 1) / G;
    const int tlast = t0 + first + (n_my - 1) * G;
    f32x4 r0[8], r1[8];
    conv_load(a, t0 + first, tid, r0);
    conv_load(a, min(t0 + first + G, tlast), tid, r1);
#pragma unroll 1
    for (int s2 = 0; s2 + 1 < n_my; s2 += 2) {
        const int tA = t0 + first + s2 * G;
        conv_emit(T, a, tA, tid, r0, true, min(tA + 2 * G, tlast), r0);
        conv_emit(T, a, tA + G, tid, r1, true, min(tA + 3 * G, tlast), r1);
    }
    if (n_my & 1) conv_emit(T, a, tlast, tid, r0, false, tlast, r0);
    __syncthreads();
}

__device__ __forceinline__ bf16x8 silu_pack8v(const f32x4 x0, const f32x4 x1) {
    u32x4 q; q.x = cvt_pk_bf16(siluf_(x0[0]), siluf_(x0[1])); q.y = cvt_pk_bf16(siluf_(x0[2]), siluf_(x0[3])); q.z = cvt_pk_bf16(siluf_(x1[0]), siluf_(x1[1])); q.w = cvt_pk_bf16(siluf_(x1[2]), siluf_(x1[3]));
    return __builtin_bit_cast(bf16x8, q);
}
__device__ __forceinline__ bf16x8 silu_pack8(const float* p) {
    const f32x4 x0 = *(const f32x4*)p, x1 = *(const f32x4*)(p + 4);
    u32x4 q; q.x = cvt_pk_bf16(siluf_(x0[0]), siluf_(x0[1])); q.y = cvt_pk_bf16(siluf_(x0[2]), siluf_(x0[3])); q.z = cvt_pk_bf16(siluf_(x1[0]), siluf_(x1[1])); q.w = cvt_pk_bf16(siluf_(x1[2]), siluf_(x1[3]));
    return __builtin_bit_cast(bf16x8, q);
}
__device__ __forceinline__ void ada_unit(LAS unsigned char* lds, const Args& a, int unit, int tid) {
    constexpr int NC = 72, PITCH = 136;
    LAS bf16_t* Bt = (LAS bf16_t*)lds;
    const float* W = a.in[7]; const float* bada = a.in[8]; const float* cp = a.in[4]; const float* cs = a.in[5];
    float* MOD = (float*)(a.ws + WS_MOD);
    const int w = tid >> 6, lane = tid & 63, fr = lane & 15, fq = lane >> 4;
    const int n0 = unit * NC;
    f32x4 acc[2][5];
#pragma unroll
    for (int mb = 0; mb < 2; ++mb)
#pragma unroll
        for (int nb = 0; nb < 5; ++nb) acc[mb][nb] = (f32x4){0.f, 0.f, 0.f, 0.f};
    const int r0 = 16 * w + fr, r1 = 128 + fr;
    const float* ap0 = (r0 < 4) ? cp + (size_t)r0 * D : cs + (size_t)(r0 - 4) * D;
    const float* ap1 = cs + (size_t)((r1 < 132 ? r1 : 131) - 4) * D;
    const bool has1 = (w == 0);
    constexpr int FP = 76;
    LAS float* F = (LAS float*)(lds + 32768);
    f32x4 r[5];
#pragma unroll
    for (int i = 0; i < 5; ++i) { const int idx = min(tid + NTHR * i, 128 * 18 - 1); const int kk = idx / 18, c4 = idx % 18;
        r[i] = __builtin_nontemporal_load((const f32x4*)(W + (size_t)kk * NMOD + n0 + 4 * c4)); }
    f32x4 xa[4][2], xb[4][2];
#define ADA_LOADA(KC) do { _Pragma("unroll") for (int ks = 0; ks < 4; ++ks) { const int k_ = (KC) + 32 * ks + 8 * fq; \
        xa[ks][0] = *(const f32x4*)(ap0 + k_); xa[ks][1] = *(const f32x4*)(ap0 + k_ + 4); xb[ks][0] = *(const f32x4*)(ap1 + k_); xb[ks][1] = *(const f32x4*)(ap1 + k_ + 4); } } while (0)
    ADA_LOADA(0);
#pragma unroll 1
    for (int kc0 = 0; kc0 < D; kc0 += 128) {
#pragma unroll
        for (int i = 0; i < 5; ++i) { const int idx = tid + NTHR * i; if (idx < 128 * 18) { const int kk = idx / 18, c4 = idx % 18; *(LAS f32x4*)(F + kk * FP + 4 * c4) = r[i]; } }
        LDSBAR2();
        { const int kn = min(kc0 + 128, D - 128);
#pragma unroll
          for (int i = 0; i < 5; ++i) { const int idx = min(tid + NTHR * i, 128 * 18 - 1); const int kk = idx / 18, c4 = idx % 18;
              r[i] = __builtin_nontemporal_load((const f32x4*)(W + (size_t)(kn + kk) * NMOD + n0 + 4 * c4)); } }
#pragma unroll
        for (int q = 0; q < 3; ++q) { const int it = tid + NTHR * q; if (it < 16 * NC) { const int kg = it / NC, n = it - kg * NC;
            float v[8];
#pragma unroll
            for (int e = 0; e < 8; ++e) v[e] = F[(8 * kg + e) * FP + n];
            *(LAS u32x4*)(Bt + n * PITCH + 8 * kg) = (u32x4){cvt_pk_bf16(v[0], v[1]), cvt_pk_bf16(v[2], v[3]), cvt_pk_bf16(v[4], v[5]), cvt_pk_bf16(v[6], v[7])}; } }
        LDSBAR2();
        bf16x8 A0[4], A1[4];
#pragma unroll
        for (int ks = 0; ks < 4; ++ks) {
            A0[ks] = silu_pack8v(xa[ks][0], xa[ks][1]);
            A1[ks] = (bf16x8){0, 0, 0, 0, 0, 0, 0, 0};
            if (has1) { const bf16x8 t1 = silu_pack8v(xb[ks][0], xb[ks][1]); if (fr < 4) A1[ks] = t1; }
        }
        ADA_LOADA(min(kc0 + 128, D - 128));
#pragma unroll
        for (int ks = 0; ks < 4; ++ks) {
#pragma unroll
            for (int nb = 0; nb < 5; ++nb) {
                const bf16x8 B = *(const LAS bf16x8*)(Bt + (16 * nb + fr) * PITCH + 32 * ks + 8 * fq);
                acc[0][nb] = __builtin_amdgcn_mfma_f32_16x16x32_bf16(A0[ks], B, acc[0][nb], 0, 0, 0);
                if (has1) acc[1][nb] = __builtin_amdgcn_mfma_f32_16x16x32_bf16(A1[ks], B, acc[1][nb], 0, 0, 0);
            }
        }
        LDSBAR2();
    }
#undef ADA_LOADA
    __syncthreads();
    float bv[5];
#pragma unroll
    for (int nb = 0; nb < 5; ++nb) { const int cl = 16 * nb + fr; bv[nb] = bada[n0 + (cl < NC ? cl : 0)]; }
#pragma unroll
    for (int mb = 0; mb < 2; ++mb) {
        if (mb == 1 && !has1) continue;
#pragma unroll
        for (int nb = 0; nb < 5; ++nb) {
            const int cl = 16 * nb + fr;
            if (cl < NC) {
#pragma unroll
                for (int j = 0; j < 4; ++j) { const int row = (mb == 0 ? 16 * w : 128) + 4 * fq + j; if (row < 132) MOD[(size_t)row * NMOD + n0 + cl] = acc[mb][nb][j] + bv[nb]; }
            }
        }
    }
}

struct SampleResid { const float* part; int nsplit; int gate_off; float rscale; };
__device__ __forceinline__ void load_row(const Args& a, int row, const void* src_p, bool p_bf16, const void* src_s, bool s_bf16, const SampleResid& sr, int lane, f32x4 (&x)[8]) {
    const bool isp = row < MP; const bool bf = isp ? p_bf16 : s_bf16;
    const size_t ro = (size_t)(isp ? row : row - MP) * D; const void* src = isp ? src_p : src_s;
    if (bf) {
#pragma unroll
        for (int i = 0; i < 8; ++i) { const u32x2 w = *(const u32x2*)((const bf16_t*)src + ro + 256 * i + 4 * lane); x[i] = (f32x4){bf_lo(w.x), bf_hi(w.x), bf_lo(w.y), bf_hi(w.y)}; }
    } else {
#pragma unroll
        for (int i = 0; i < 8; ++i) x[i] = *(const f32x4*)((const float*)src + ro + 256 * i + 4 * lane);
    }
    if (row >= MP && sr.part) {
        const float* gp = (const float*)(a.ws + WS_MOD) + (size_t)modrow_of(row) * NMOD + sr.gate_off;
        bf16_t* Xr = (bf16_t*)(a.ws + WS_X) + (size_t)row * D;
        f32x4 p[8], gv[8];
#pragma unroll
        for (int i = 0; i < 8; ++i) { p[i] = (f32x4){0.f, 0.f, 0.f, 0.f}; gv[i] = *(const f32x4*)(gp + 256 * i + 4 * lane); }
        const float* pr = sr.part + (size_t)(row - MP) * D + 4 * lane;
#pragma unroll 2
        for (int sp = 0; sp < sr.nsplit; ++sp) {
            f32x4 t[8];
#pragma unroll
            for (int i = 0; i < 8; ++i) t[i] = *(const f32x4*)(pr + 256 * i);
#pragma unroll
            for (int i = 0; i < 8; ++i) p[i] += t[i];
            pr += (size_t)128 * D;
        }
#pragma unroll
        for (int i = 0; i < 8; ++i) { x[i] += sr.rscale * gv[i] * p[i]; *(u32x2*)(Xr + 256 * i + 4 * lane) = (u32x2){cvt_pk_bf16(x[i][0], x[i][1]), cvt_pk_bf16(x[i][2], x[i][3])}; }
    }
}
__device__ __forceinline__ float sample_row(LAS float* red, const Args& a, int si, const void* src_s, bool s_bf16, const SampleResid& sr, int wave, int lane, f32x4& x) {
    const int c = 256 * wave + 4 * lane; const int row = MP + si;
    if (s_bf16) { const u32x2 w = *(const u32x2*)((const bf16_t*)src_s + (size_t)si * D + c); x = (f32x4){bf_lo(w.x), bf_hi(w.x), bf_lo(w.y), bf_hi(w.y)}; }
    else x = *(const f32x4*)((const float*)src_s + (size_t)si * D + c);
    if (sr.part) {
        const f32x4 gv = *(const f32x4*)((const float*)(a.ws + WS_MOD) + (size_t)modrow_of(row) * NMOD + sr.gate_off + c);
        const float* pr = sr.part + (size_t)si * D + c;
        f32x4 p = (f32x4){0.f, 0.f, 0.f, 0.f};
#pragma unroll 8
        for (int sp = 0; sp < sr.nsplit; ++sp) p += *(const f32x4*)(pr + (size_t)sp * 128 * D);
        x += sr.rscale * gv * p;
        *(u32x2*)((bf16_t*)(a.ws + WS_X) + (size_t)row * D + c) = (u32x2){cvt_pk_bf16(x[0], x[1]), cvt_pk_bf16(x[2], x[3])};
    }
    float ss = x[0] * x[0] + x[1] * x[1] + x[2] * x[2] + x[3] * x[3];
#pragma unroll
    for (int o = 32; o >= 1; o >>= 1) ss += __shfl_xor(ss, o);
    __syncthreads();
    if (lane == 0) red[wave] = ss;
    __syncthreads();
    float tot = 0.f;
#pragma unroll
    for (int w8 = 0; w8 < 8; ++w8) tot += red[w8];
    return rsqrtf(tot * (1.0f / D) + EPS);
}
__device__ __forceinline__ void rows_phase(const Args& a, const void* src_p, bool p_bf16, const void* src_s, bool s_bf16, const float* g, int sh_off, int sc_off, bool zero_pad, const SampleResid sr, int tid, LAS unsigned char* lds) {
    const float* MOD = (const float*)(a.ws + WS_MOD);
    bf16_t* H = (bf16_t*)(a.ws + WS_H);
    const int lane = tid & 63, gw = blockIdx.x * 8 + (tid >> 6), nw = gridDim.x * 8;
    if (zero_pad) for (int row = MR + gw; row < MPAD; row += nw) {
#pragma unroll
        for (int i = 0; i < 8; ++i) *(u32x2*)(H + (size_t)row * D + 256 * i + 4 * lane) = (u32x2){0u, 0u};
    }
    for (int si = blockIdx.x; si < MS; si += gridDim.x) {
        const int wave = tid >> 6, c = 256 * wave + 4 * lane, row = MP + si;
        f32x4 x;
        const float rstd = sample_row((LAS float*)lds, a, si, src_s, s_bf16, sr, wave, lane, x);
        const float* mp = MOD + (size_t)modrow_of(row) * NMOD;
        const f32x4 gv = *(const f32x4*)(g + c), sc = *(const f32x4*)(mp + sc_off + c), sh = *(const f32x4*)(mp + sh_off + c);
        const f32x4 h = x * rstd * gv * (1.0f + sc) + sh;
        *(u32x2*)(H + (size_t)row * D + c) = (u32x2){cvt_pk_bf16(h[0], h[1]), cvt_pk_bf16(h[2], h[3])};
    }
    for (int row = gw; row < MP; row += nw) {
        bf16_t* hp = H + (size_t)row * D;
        f32x4 x[8]; float ss = 0.f;
        load_row(a, row, src_p, p_bf16, src_s, s_bf16, sr, lane, x);
#pragma unroll
        for (int i = 0; i < 8; ++i) ss += x[i][0] * x[i][0] + x[i][1] * x[i][1] + x[i][2] * x[i][2] + x[i][3] * x[i][3];
#pragma unroll
        for (int o = 32; o >= 1; o >>= 1) ss += __shfl_xor(ss, o);
        const float rstd = rsqrtf(ss * (1.0f / D) + EPS);
        const float* mp = MOD + (size_t)modrow_of(row) * NMOD;
#pragma unroll
        for (int hf = 0; hf < 2; ++hf) {
            f32x4 gv[4], sc[4], sh[4];
#pragma unroll
            for (int i = 0; i < 4; ++i) { const int c = 256 * (4 * hf + i) + 4 * lane; gv[i] = *(const f32x4*)(g + c); sc[i] = *(const f32x4*)(mp + sc_off + c); sh[i] = *(const f32x4*)(mp + sh_off + c); }
#pragma unroll
            for (int i = 0; i < 4; ++i) { const int c = 256 * (4 * hf + i) + 4 * lane;
                const f32x4 h = x[4 * hf + i] * rstd * gv[i] * (1.0f + sc[i]) + sh[i];
                __hip_atomic_store((unsigned long long*)(hp + c), ((unsigned long long)cvt_pk_bf16(h[2], h[3]) << 32) | cvt_pk_bf16(h[0], h[1]), __ATOMIC_RELAXED, __HIP_MEMORY_SCOPE_AGENT); }
        }
    }
}
__device__ __forceinline__ void final_phase(const Args& a, const SampleResid sr, int tid, LAS unsigned char* lds) {
    const bf16_t* X = (const bf16_t*)(a.ws + WS_X); const float* g = a.in[22];
    const int lane = tid & 63, gw = blockIdx.x * 8 + (tid >> 6), nw = gridDim.x * 8;
    for (int si = blockIdx.x; si < MS; si += gridDim.x) {
        const int wave = tid >> 6, c = 256 * wave + 4 * lane;
        f32x4 x;
        const float rstd = sample_row((LAS float*)lds, a, si, X + (size_t)MP * D, true, sr, wave, lane, x);
        __builtin_nontemporal_store(x * rstd * *(const f32x4*)(g + c), (f32x4*)(a.out + OUT_Y + (size_t)(MP + si) * D + c));
    }
    for (int row = gw; row < MP; row += nw) {
        float* yp = a.out + OUT_Y + (size_t)row * D;
        f32x4 x[8]; float ss = 0.f;
        load_row(a, row, X, true, X + (size_t)MP * D, true, sr, lane, x);
#pragma unroll
        for (int i = 0; i < 8; ++i) ss += x[i][0] * x[i][0] + x[i][1] * x[i][1] + x[i][2] * x[i][2] + x[i][3] * x[i][3];
#pragma unroll
        for (int o = 32; o >= 1; o >>= 1) ss += __shfl_xor(ss, o);
        const float rstd = rsqrtf(ss * (1.0f / D) + EPS);
        f32x4 gv[8];
#pragma unroll
        for (int i = 0; i < 8; ++i) gv[i] = *(const f32x4*)(g + 256 * i + 4 * lane);
#pragma unroll
        for (int i = 0; i < 8; ++i) { const int c = 256 * i + 4 * lane; __builtin_nontemporal_store(x[i] * rstd * gv[i], (f32x4*)(yp + c)); }
    }
}

constexpr int HP = 136, SP = 40, OBP = 132;
constexpr int L_QT = 0, L_QE = L_QT + 32 * HP * 2, L_KT = L_QE + 32 * HP * 2, L_KET = L_KT + 32 * HP * 2, L_VT = L_KET + 128 * SP * 2, L_ST = L_VT + 128 * SP * 2,
              L_ATT = L_ST + 128 * HP * 2, L_OB = L_ATT + 32 * SP * 2, L_PART = L_OB + 32 * OBP * 4, L_EB = L_PART + 4 * 128 * 4, L_HEND = L_EB + 128 * 4;
static_assert(L_HEND <= 131072, "hgrn lds");

#define LDSBAR() asm volatile("s_waitcnt lgkmcnt(0)\n\ts_barrier" ::: "memory")

constexpr int A_P = 136;
constexpr int LA_KET = 0, LA_VT = LA_KET + 128 * A_P * 2, LA_PART = LA_VT + 128 * A_P * 2, LA_EB = LA_PART + 4 * 128 * 4;
__device__ __forceinline__ void hgrn_passA(LAS unsigned char* lds, const Args& a, int bh, int j, int tid) {
    const int w = tid >> 6, lane = tid & 63, fr = lane & 15, fq = lane >> 4;
    const int kch = tid & 127, tq = tid >> 7;
    const int b = bh >> 3, h = bh & 7;
    const bf16_t* Kb = (const bf16_t*)(a.ws + WS_K); const bf16_t* Vb = (const bf16_t*)(a.ws + WS_V); const float* LF = (const float*)(a.ws + WS_LF);
    float* LLOC = (float*)(a.ws + WS_LLOC); float* DLOC = (float*)(a.ws + WS_DLOC);
    LAS bf16_t* KET = (LAS bf16_t*)(lds + LA_KET); LAS bf16_t* VT = (LAS bf16_t*)(lds + LA_VT); LAS float* PART = (LAS float*)(lds + LA_PART); LAS float* EB = (LAS float*)(lds + LA_EB);
    f32x4 accS[8];
#pragma unroll
    for (int kb = 0; kb < 8; ++kb) accS[kb] = (f32x4){0.f, 0.f, 0.f, 0.f};
    float btot = 0.f;
    const int row0 = b * SEQ + j * 256;
    const int vs = tid & 31, vc8 = tid >> 5;
#pragma unroll 1
    for (int c = 0; c < 2; ++c) {
        const int rowc = row0 + 128 * c;
        float cs[32], kk[32];
        {   const float* pl = LF + (size_t)(rowc + 32 * tq) * DA + 128 * h + kch; const bf16_t* pk = Kb + (size_t)(rowc + 32 * tq) * DA + 128 * h + kch;
#pragma unroll
            for (int i = 0; i < 32; ++i) { cs[i] = *pl; kk[i] = bf2f(*pk); pl += DA; pk += DA; asm("" : "+v"(pl), "+v"(pk)); } }
        u32x4 v16[4];
        {   const bf16_t* pv = Vb + (size_t)(rowc + vs) * DA + 128 * h + 8 * vc8;
#pragma unroll
            for (int i = 0; i < 4; ++i) { v16[i] = *(const u32x4*)pv; pv += 32 * DA; asm("" : "+v"(pv)); } }
#pragma unroll
        for (int i = 1; i < 32; ++i) cs[i] += cs[i - 1];
        PART[tq * 128 + kch] = cs[31];
#pragma unroll
        for (int i = 0; i < 4; ++i) {
            LAS bf16_t* p = VT + (8 * vc8) * A_P + vs + 32 * i;
            p[0] = (bf16_t)(v16[i].x & 0xffffu); p[A_P] = (bf16_t)(v16[i].x >> 16); p[2 * A_P] = (bf16_t)(v16[i].y & 0xffffu); p[3 * A_P] = (bf16_t)(v16[i].y >> 16);
            p[4 * A_P] = (bf16_t)(v16[i].z & 0xffffu); p[5 * A_P] = (bf16_t)(v16[i].z >> 16); p[6 * A_P] = (bf16_t)(v16[i].w & 0xffffu); p[7 * A_P] = (bf16_t)(v16[i].w >> 16);
        }
        LDSBAR();
        const float p0 = PART[kch], p1 = PART[128 + kch], p2 = PART[256 + kch], p3 = PART[384 + kch];
        const float offs = (tq > 0 ? p0 : 0.f) + (tq > 1 ? p1 : 0.f) + (tq > 2 ? p2 : 0.f);
        const float Bc = (p0 + p1) + (p2 + p3);
#pragma unroll
        for (int g8 = 0; g8 < 4; ++g8) {
            float ke[8];
#pragma unroll
            for (int e = 0; e < 8; ++e) ke[e] = kk[8 * g8 + e] * __expf(Bc - (offs + cs[8 * g8 + e]));
            *(LAS u32x4*)(KET + kch * A_P + 32 * tq + 8 * g8) = (u32x4){cvt_pk_bf16(ke[0], ke[1]), cvt_pk_bf16(ke[2], ke[3]), cvt_pk_bf16(ke[4], ke[5]), cvt_pk_bf16(ke[6], ke[7])};
        }
        if (tq == 0) EB[kch] = __expf(Bc);
        btot += Bc;
        LDSBAR();
#pragma unroll
        for (int kb = 0; kb < 8; ++kb) accS[kb] *= *(const LAS f32x4*)(EB + 16 * kb + 4 * fq);
#pragma unroll
        for (int ks = 0; ks < 4; ++ks) {
            const bf16x8 Bv = *(const LAS bf16x8*)(VT + (16 * w + fr) * A_P + 32 * ks + 8 * fq);
#pragma unroll
            for (int kb = 0; kb < 8; ++kb) {
                const bf16x8 A = *(const LAS bf16x8*)(KET + (16 * kb + fr) * A_P + 32 * ks + 8 * fq);
                accS[kb] = __builtin_amdgcn_mfma_f32_16x16x32_bf16(A, Bv, accS[kb], 0, 0, 0);
            }
        }
        LDSBAR();
    }
    float* Lp = LLOC + (size_t)(bh * 8 + j) * 128 * 128;
#pragma unroll
    for (int kb = 0; kb < 8; ++kb) *(f32x4*)(Lp + ((size_t)(w * 8 + kb) * 64 + lane) * 4) = accS[kb];
    if (tq == 0) DLOC[(size_t)(bh * 8 + j) * 128 + kch] = __expf(btot);
    __syncthreads();
}

#define HB_LOAD(cc, LFv, KKv, QQv, VV, GG) do { const int rc_ = row0 + 32 * (cc); \
    _Pragma("unroll") for (int i = 0; i < 8; ++i) { const size_t off_ = (size_t)(rc_ + 8 * tq + i) * DA + 128 * h + kch; LFv[i] = LF[off_]; KKv[i] = Kb[off_]; QQv[i] = Qb[off_]; } \
    VV = *(const u32x4*)(Vb + (size_t)(rc_ + vs2) * DA + 128 * h + 8 * vc82); GG = *(const u32x4*)(GT + (size_t)(rc_ + vs) * DA + 128 * h + 8 * vc8); } while (0)
__device__ __forceinline__ void hgrn_passB(LAS unsigned char* lds, const Args& a, int bh, int j, int tid) {
    const int w = tid >> 6, lane = tid & 63, fr = lane & 15, fq = lane >> 4;
    const int kch = tid & 127, tq = tid >> 7;
    const int b = bh >> 3, h = bh & 7;
    const bf16_t* Qb = (const bf16_t*)(a.ws + WS_Q); const bf16_t* Kb = (const bf16_t*)(a.ws + WS_K); const bf16_t* Vb = (const bf16_t*)(a.ws + WS_V);
    const bf16_t* GT = (const bf16_t*)(a.ws + WS_GT); const float* LF = (const float*)(a.ws + WS_LF);
    bf16_t* OMIX = (bf16_t*)(a.ws + WS_OMIX);
    const float* LLOC = (const float*)(a.ws + WS_LLOC); const float* DLOC = (const float*)(a.ws + WS_DLOC);
    LAS bf16_t* QT = (LAS bf16_t*)(lds + L_QT); LAS bf16_t* QE = (LAS bf16_t*)(lds + L_QE); LAS bf16_t* KT = (LAS bf16_t*)(lds + L_KT);
    LAS bf16_t* KET = (LAS bf16_t*)(lds + L_KET); LAS bf16_t* VT = (LAS bf16_t*)(lds + L_VT); LAS bf16_t* ST = (LAS bf16_t*)(lds + L_ST);
    LAS bf16_t* ATT = (LAS bf16_t*)(lds + L_ATT); LAS float* OB = (LAS float*)(lds + L_OB); LAS float* PART = (LAS float*)(lds + L_PART); LAS float* EB = (LAS float*)(lds + L_EB);
    const int row0 = b * SEQ + j * 256;
    const int vs = tid >> 4, vc8 = tid & 15;
    const int vs2 = tid & 31, vc82 = tid >> 5;
    float lf_c[8]; bf16_t kk_c[8], q_c[8]; u32x4 v_c, g_c;
    HB_LOAD(0, lf_c, kk_c, q_c, v_c, g_c);
    f32x4 accS[8];
#pragma unroll
    for (int kb = 0; kb < 8; ++kb) accS[kb] = (f32x4){0.f, 0.f, 0.f, 0.f};
    for (int jj = 0; jj < j; ++jj) {
        const float* Lp = LLOC + (size_t)(bh * 8 + jj) * 128 * 128; const float* Dp = DLOC + (size_t)(bh * 8 + jj) * 128;
        f32x4 dv[8], lv[8];
#pragma unroll
        for (int kb = 0; kb < 8; ++kb) { dv[kb] = *(const f32x4*)(Dp + 16 * kb + 4 * fq);
            lv[kb] = *(const f32x4*)(Lp + ((size_t)(w * 8 + kb) * 64 + lane) * 4); }
#pragma unroll
        for (int kb = 0; kb < 8; ++kb) accS[kb] = dv[kb] * accS[kb] + lv[kb];
    }
    const float* gn = a.in[14] + 128 * h + 8 * vc8;
    const f32x4 gn0 = *(const f32x4*)gn, gn1 = *(const f32x4*)(gn + 4);
#pragma unroll 1
    for (int c = 0; c < 8; ++c) {
        const int rowc = row0 + 32 * c;
        float lf_n[8]; bf16_t kk_n[8], q_n[8]; u32x4 v_n, g_n;
        if (c < 7) HB_LOAD(c + 1, lf_n, kk_n, q_n, v_n, g_n);
        else {
#pragma unroll
            for (int i = 0; i < 8; ++i) { lf_n[i] = 0.f; kk_n[i] = 0; q_n[i] = 0; }
            v_n = (u32x4){0u, 0u, 0u, 0u}; g_n = v_n;
        }
        float cs[8];
#pragma unroll
        for (int i = 0; i < 8; ++i) cs[i] = lf_c[i];
#pragma unroll
        for (int i = 1; i < 8; ++i) cs[i] += cs[i - 1];
        PART[tq * 128 + kch] = cs[7];
        {
            LAS bf16_t* p = VT + (8 * vc82) * SP + vs2;
            p[0] = (bf16_t)(v_c.x & 0xffffu); p[SP] = (bf16_t)(v_c.x >> 16); p[2 * SP] = (bf16_t)(v_c.y & 0xffffu); p[3 * SP] = (bf16_t)(v_c.y >> 16);
            p[4 * SP] = (bf16_t)(v_c.z & 0xffffu); p[5 * SP] = (bf16_t)(v_c.z >> 16); p[6 * SP] = (bf16_t)(v_c.w & 0xffffu); p[7 * SP] = (bf16_t)(v_c.w >> 16);
        }
#pragma unroll
        for (int kb = 0; kb < 8; ++kb)
            *(LAS u32x2*)(ST + (16 * w + fr) * HP + 16 * kb + 4 * fq) = (u32x2){cvt_pk_bf16(accS[kb][0], accS[kb][1]), cvt_pk_bf16(accS[kb][2], accS[kb][3])};
        LDSBAR();
        const float p0 = PART[kch], p1 = PART[128 + kch], p2 = PART[256 + kch], p3 = PART[384 + kch];
        const float offs = (tq > 0 ? p0 : 0.f) + (tq > 1 ? p1 : 0.f) + (tq > 2 ? p2 : 0.f);
        const float mref = p0 + p1, Bc = (p0 + p1) + (p2 + p3);
        float ke[8];
#pragma unroll
        for (int i = 0; i < 8; ++i) {
            const float bb = offs + cs[i], kkf = bf2f(kk_c[i]), qf = bf2f(q_c[i]);
            ke[i] = kkf * __expf(Bc - bb);
            const int t = 8 * tq + i;
            QT[t * HP + kch] = f2bf(qf * __expf(bb - mref));
            QE[t * HP + kch] = f2bf(qf * __expf(bb));
            KT[t * HP + kch] = f2bf(kkf * __expf(mref - bb));
        }
        *(LAS u32x4*)(KET + kch * SP + 8 * tq) = (u32x4){cvt_pk_bf16(ke[0], ke[1]), cvt_pk_bf16(ke[2], ke[3]), cvt_pk_bf16(ke[4], ke[5]), cvt_pk_bf16(ke[6], ke[7])};
        if (tq == 0) EB[kch] = __expf(Bc);
        LDSBAR();
        if (w < 4) {
            const int tb = w >> 1, sb = w & 1;
            f32x4 at = (f32x4){0.f, 0.f, 0.f, 0.f};
#pragma unroll
            for (int ks = 0; ks < 4; ++ks) {
                const bf16x8 A = *(const LAS bf16x8*)(QT + (16 * tb + fr) * HP + 32 * ks + 8 * fq);
                const bf16x8 B = *(const LAS bf16x8*)(KT + (16 * sb + fr) * HP + 32 * ks + 8 * fq);
                at = __builtin_amdgcn_mfma_f32_16x16x32_bf16(A, B, at, 0, 0, 0);
            }
#pragma unroll
            for (int i = 0; i < 4; ++i) { const int t = 16 * tb + 4 * fq + i, s = 16 * sb + fr; ATT[t * SP + s] = (s <= t) ? f2bf(at[i]) : (bf16_t)0; }
        }
        f32x4 ao[2] = {(f32x4){0.f, 0.f, 0.f, 0.f}, (f32x4){0.f, 0.f, 0.f, 0.f}};
#pragma unroll
        for (int ks = 0; ks < 4; ++ks) {
            const bf16x8 B = *(const LAS bf16x8*)(ST + (16 * w + fr) * HP + 32 * ks + 8 * fq);
#pragma unroll
            for (int tb = 0; tb < 2; ++tb) {
                const bf16x8 A = *(const LAS bf16x8*)(QE + (16 * tb + fr) * HP + 32 * ks + 8 * fq);
                ao[tb] = __builtin_amdgcn_mfma_f32_16x16x32_bf16(A, B, ao[tb], 0, 0, 0);
            }
        }
        LDSBAR();
        {
            const bf16x8 Bv = *(const LAS bf16x8*)(VT + (16 * w + fr) * SP + 8 * fq);
#pragma unroll
            for (int tb = 0; tb < 2; ++tb) {
                const bf16x8 A = *(const LAS bf16x8*)(ATT + (16 * tb + fr) * SP + 8 * fq);
                ao[tb] = __builtin_amdgcn_mfma_f32_16x16x32_bf16(A, Bv, ao[tb], 0, 0, 0);
#pragma unroll
                for (int i = 0; i < 4; ++i) OB[(16 * tb + 4 * fq + i) * OBP + 16 * w + fr] = ao[tb][i];
            }
#pragma unroll
            for (int kb = 0; kb < 8; ++kb) {
                const f32x4 eb = *(const LAS f32x4*)(EB + 16 * kb + 4 * fq);
                const bf16x8 A = *(const LAS bf16x8*)(KET + (16 * kb + fr) * SP + 8 * fq);
                accS[kb] = __builtin_amdgcn_mfma_f32_16x16x32_bf16(A, Bv, accS[kb] * eb, 0, 0, 0);
            }
        }
        LDSBAR();
        {
            const f32x4 o0 = *(const LAS f32x4*)(OB + vs * OBP + 8 * vc8), o1 = *(const LAS f32x4*)(OB + vs * OBP + 8 * vc8 + 4);
            float ss = o0[0] * o0[0] + o0[1] * o0[1] + o0[2] * o0[2] + o0[3] * o0[3] + o1[0] * o1[0] + o1[1] * o1[1] + o1[2] * o1[2] + o1[3] * o1[3];
            ss += __shfl_xor(ss, 1); ss += __shfl_xor(ss, 2); ss += __shfl_xor(ss, 4); ss += __shfl_xor(ss, 8);
            const float rstd = rsqrtf(ss * (1.0f / 128.0f) + EPS);
            u32x4 o;
            o.x = cvt_pk_bf16(o0[0] * rstd * gn0[0] * bf_lo(g_c.x), o0[1] * rstd * gn0[1] * bf_hi(g_c.x));
            o.y = cvt_pk_bf16(o0[2] * rstd * gn0[2] * bf_lo(g_c.y), o0[3] * rstd * gn0[3] * bf_hi(g_c.y));
            o.z = cvt_pk_bf16(o1[0] * rstd * gn1[0] * bf_lo(g_c.z), o1[1] * rstd * gn1[1] * bf_hi(g_c.z));
            o.w = cvt_pk_bf16(o1[2] * rstd * gn1[2] * bf_lo(g_c.w), o1[3] * rstd * gn1[3] * bf_hi(g_c.w));
            *(u32x4*)(OMIX + (size_t)(rowc + vs) * D + 128 * h + 8 * vc8) = o;
        }
#pragma unroll
        for (int i = 0; i < 8; ++i) { lf_c[i] = lf_n[i]; kk_c[i] = kk_n[i]; q_c[i] = q_n[i]; }
        v_c = v_n; g_c = g_n;
    }
    if (j == 7) {
        float* Sp = a.out + OUT_HP + (size_t)bh * 128 * 128;
#pragma unroll
        for (int kb = 0; kb < 8; ++kb)
#pragma unroll
            for (int i = 0; i < 4; ++i) Sp[(size_t)(16 * kb + 4 * fq + i) * 128 + 16 * w + fr] = accS[kb][i];
    }
    __syncthreads();
}

template <int NV>
__device__ __forceinline__ void block_reduce(LAS float* red, float (&v)[NV], int tid) {
    const int w = tid >> 6, lane = tid & 63;
#pragma unroll
    for (int i = 0; i < NV; ++i) {
#pragma unroll
        for (int o = 32; o >= 1; o >>= 1) v[i] += __shfl_xor(v[i], o);
    }
    __syncthreads();
    if (lane == 0) {
#pragma unroll
        for (int i = 0; i < NV; ++i) red[w * NV + i] = v[i];
    }
    __syncthreads();
#pragma unroll
    for (int i = 0; i < NV; ++i) { float s = 0.f;
#pragma unroll
        for (int ww = 0; ww < 8; ++ww) s += red[ww * NV + i];
        v[i] = s; }
}
__device__ __forceinline__ void conv_prompt_phase(LAS unsigned char* lds, const Args& a, int tid) {
    constexpr int T = 8;
    const bf16_t* U = (const bf16_t*)(a.ws + WS_U); bf16_t* OMIX = (bf16_t*)(a.ws + WS_OMIX);
    const float* cw = a.in[15]; const float* cb = a.in[16]; const float* lg = a.in[17]; const float* lb = a.in[18];
    const int c = 2 * tid;
    f32x2 wv[CW];
    { const char* pw = (const char*)(cw + c);
#pragma unroll
      for (int jx = 0; jx < CW; ++jx) { wv[jx] = *(const f32x2*)pw; pw += 4096; asm("" : "+v"(pw)); } }
    const f32x2 cbv = *(const f32x2*)(cb + c), lgv = *(const f32x2*)(lg + c), lbv = *(const f32x2*)(lb + c);
    const int vb = (gridDim.x % 8 == 0) ? (int)((blockIdx.x & 7) * (gridDim.x >> 3) + (blockIdx.x >> 3)) : (int)blockIdx.x;
#pragma unroll 1
    for (int unit = vb; unit < NBATCH * (SEQ / T); unit += gridDim.x) {
        const int b = unit / (SEQ / T), t0 = (unit % (SEQ / T)) * T, rbase = b * SEQ;
        f32x2 y[T];
#pragma unroll
        for (int t = 0; t < T; ++t) y[t] = cbv;
        const char* pu = (const char*)(U + ((long)rbase + t0 - 30) * DA + c);
#pragma unroll
        for (int r = 0; r < T + 30; ++r) {
            const int tok = t0 - 30 + r; unsigned x = 0u;
            if (tok >= 0) x = *(const unsigned*)pu;
            pu += DA * 2; asm("" : "+v"(pu));
            const f32x2 xv = (f32x2){bf_lo(x), bf_hi(x)};
#pragma unroll
            for (int t = 0; t < T; ++t) { const int jx = r - t; if (jx >= 0 && jx < CW) y[t] += wv[jx] * xv; }
        }
        float st[2 * T];
#pragma unroll
        for (int t = 0; t < T; ++t) { st[t] = y[t].x + y[t].y; st[T + t] = y[t].x * y[t].x + y[t].y * y[t].y; }
        block_reduce<2 * T>((LAS float*)lds, st, tid);
#pragma unroll
        for (int t = 0; t < T; ++t) {
            const float mean = st[t] * (1.0f / 1024.0f), var = fmaxf(st[T + t] * (1.0f / 1024.0f) - mean * mean, 0.f), rstd = rsqrtf(var + EPS);
            const float z0 = (y[t].x - mean) * rstd * lgv.x + lbv.x, z1 = (y[t].y - mean) * rstd * lgv.y + lbv.y;
            *(unsigned*)(OMIX + (size_t)(rbase + t0 + t) * D + 1024 + c) = cvt_pk_bf16(siluf_(z0), siluf_(z1));
        }
        __syncthreads();
    }
}
__device__ __forceinline__ void conv_sample_unit(LAS unsigned char* lds, const Args& a, int i, int tid) {
    const bf16_t* U = (const bf16_t*)(a.ws + WS_U); bf16_t* OMIX = (bf16_t*)(a.ws + WS_OMIX);
    const float* cw = a.in[15]; const float* cb = a.in[16]; const float* lg = a.in[17]; const float* lb = a.in[18];
    const float* sc = a.in[3] + (size_t)i * 30 * 1024; float* ncs = a.out + OUT_CS + (size_t)i * 30 * 1024;
    const int c = 2 * tid;
    const f32x2 cbv = *(const f32x2*)(cb + c);
    float y0 = cbv.x, y1 = cbv.y;
    const char* ps = (const char*)(sc + c); const char* pw = (const char*)(cw + c); char* pn = (char*)(ncs + c);
    f32x2 sv[30];
#pragma unroll
    for (int r = 0; r < 30; ++r) {
        sv[r] = *(const f32x2*)ps; const f32x2 wv = *(const f32x2*)pw;
        y0 += wv.x * sv[r].x; y1 += wv.y * sv[r].y;
        ps += 4096; pw += 4096; asm("" : "+v"(ps), "+v"(pw));
    }
#pragma unroll
    for (int r = 1; r < 30; ++r) { __builtin_nontemporal_store(sv[r], (f32x2*)pn); pn += 4096; asm("" : "+v"(pn)); }
    {
        const float* P = (const float*)(a.ws + WS_PART); const float* b_in = a.in[13];
        const int na = 4096 + (c >> 7) * 256 + (c & 127);
        f32x2 za = *(const f32x2*)(b_in + 4096 + c), zb = *(const f32x2*)(b_in + 5120 + c);
        f32x2 pa[NS_IN], pb[NS_IN];
#pragma unroll
        for (int sp = 0; sp < NS_IN; ++sp) { const float* pr = P + ((size_t)sp * 128 + i) * DIN + na; pa[sp] = *(const f32x2*)pr; pb[sp] = *(const f32x2*)(pr + 128); }
#pragma unroll
        for (int sp = 0; sp < NS_IN; ++sp) { za += pa[sp]; zb += pb[sp]; }
        const f32x2 uv = (f32x2){za.x * sigmoidf_(zb.x), za.y * sigmoidf_(zb.y)};
        *(f32x2*)(ncs + 29 * 1024 + c) = uv;
        const f32x2 wv = *(const f32x2*)pw; y0 += wv.x * uv.x; y1 += wv.y * uv.y; }
    float st[2] = {y0 + y1, y0 * y0 + y1 * y1};
    block_reduce<2>((LAS float*)lds, st, tid);
    const float mean = st[0] * (1.0f / 1024.0f), var = fmaxf(st[1] * (1.0f / 1024.0f) - mean * mean, 0.f), rstd = rsqrtf(var + EPS);
    const f32x2 lgv = *(const f32x2*)(lg + c), lbv = *(const f32x2*)(lb + c);
    const float z0 = (y0 - mean) * rstd * lgv.x + lbv.x, z1 = (y1 - mean) * rstd * lgv.y + lbv.y;
    *(unsigned*)(OMIX + (size_t)(MP + i) * D + 1024 + c) = cvt_pk_bf16(siluf_(z0), siluf_(z1));
    __syncthreads();
}
__device__ __forceinline__ void hgrn_sample_unit(LAS unsigned char* lds, const Args& a, int unit, int tid) {
    const int i = unit >> 3, h = unit & 7, row = MP + i;
    bf16_t* OMIX = (bf16_t*)(a.ws + WS_OMIX);
    const float* S0 = a.in[2] + (size_t)unit * 128 * 128; float* S1 = a.out + OUT_HS + (size_t)unit * 128 * 128;
    LAS float* RED = (LAS float*)lds;
    LAS float* R2 = (LAS float*)(lds + 8192);
    LAS float* ZQ = (LAS float*)(lds + 8448);
    const int v4 = tid & 31, kr = tid >> 5;
    f32x4 s0v[8];
#pragma unroll
    for (int ii = 0; ii < 8; ++ii) s0v[ii] = __builtin_nontemporal_load((const f32x4*)(S0 + (size_t)(kr + 16 * ii) * 128 + 4 * v4));
    {
        const float* P = (const float*)(a.ws + WS_PART); const float* b_in = a.in[13]; const float* lbl = a.in[6];
        const int which = tid >> 7, k = tid & 127, n = which * 1024 + 128 * h + k;
        float z = b_in[n]; float pz[NS_IN];
#pragma unroll
        for (int sp = 0; sp < NS_IN; ++sp) pz[sp] = P[((size_t)sp * 128 + i) * DIN + n];
#pragma unroll
        for (int sp = 0; sp < NS_IN; ++sp) z += pz[sp];
        if (which == 0) ZQ[k] = siluf_(z);
        else if (which == 1) { const float l0 = lbl[128 * h + k], l1 = lbl[1024 + 128 * h + k]; const float oml = 1.0f - 1.0f / (1.0f + __expf(l1 - l0));
            const float kk = oml * sigmoidf_(-z); ZQ[128 + k] = 1.0f - kk; ZQ[256 + k] = kk; }
        else if (which == 2) ZQ[384 + k] = z;
        else ZQ[512 + k] = siluf_(z);
    }
    __syncthreads();
    const f32x4 vv = *(const LAS f32x4*)(ZQ + 384 + 4 * v4);
    f32x4 acc = (f32x4){0.f, 0.f, 0.f, 0.f};
#pragma unroll
    for (int ii = 0; ii < 8; ++ii) {
        const int k = kr + 16 * ii;
        const float f = ZQ[128 + k], kkv = ZQ[256 + k], qk = ZQ[k];
        const f32x4 s0 = s0v[ii];
        const f32x4 sn = f * s0 + kkv * vv;
        __builtin_nontemporal_store(sn, (f32x4*)(S1 + (size_t)k * 128 + 4 * v4));
        acc += qk * sn;
    }
    *(LAS f32x4*)(RED + kr * 128 + 4 * v4) = acc;
    __syncthreads();
    float o = 0.f;
    if (tid < 128) {
#pragma unroll
        for (int r = 0; r < 16; ++r) o += RED[r * 128 + tid];
        float ss = o * o;
#pragma unroll
        for (int x = 32; x >= 1; x >>= 1) ss += __shfl_xor(ss, x);
        if ((tid & 63) == 0) R2[tid >> 6] = ss;
    }
    __syncthreads();
    if (tid < 128) {
        const float rstd = rsqrtf((R2[0] + R2[1]) * (1.0f / 128.0f) + EPS);
        OMIX[(size_t)row * D + 128 * h + tid] = f2bf(o * rstd * a.in[14][128 * h + tid] * ZQ[512 + tid]);
    }
    __syncthreads();
}


#define XB_TMO      128
#define XB_XCNT(j)  (256  + 64 * (j))
#define XB_XSUB(j)  (1280 + 64 * (j))
#define XB_XGEN(j)  (2304 + 64 * (j))
#define XB_TOP      3328
#define XB_TOPGEN   3392
#define XCD_BAR_WORDS 3456
#define XB_SPIN_CAP (1u << 18)
__device__ __forceinline__ unsigned xb_ld(unsigned* p)              { return __hip_atomic_load(p, __ATOMIC_RELAXED, __HIP_MEMORY_SCOPE_AGENT); }
__device__ __forceinline__ unsigned xb_add(unsigned* p, unsigned v) { return __hip_atomic_fetch_add(p, v, __ATOMIC_RELAXED, __HIP_MEMORY_SCOPE_AGENT); }
__device__ __forceinline__ unsigned xb_xcc_id() { return (unsigned)__builtin_amdgcn_s_getreg((3 << 11) | 20) & 0xFu; }
#define XB_SPIN(cond, bar) do { unsigned _sp = 0; while (cond) { __builtin_amdgcn_s_sleep(1); \
    if ((++_sp & 255u) == 0u) { if (xb_ld(&(bar)[XB_TMO])) break; if (_sp > XB_SPIN_CAP) { atomicAdd(&(bar)[XB_TMO], 1u); break; } } } } while (0)
struct XcdBarrier { unsigned* bar; unsigned x; volatile LAS unsigned* st; };
__device__ __forceinline__ XcdBarrier xcd_barrier_post(unsigned* bar, volatile LAS unsigned* st) {
    XcdBarrier b; b.bar = bar; b.x = xb_xcc_id(); b.st = st;
    if (threadIdx.x == 0) (void)xb_add(&bar[XB_XCNT(b.x)], 1u);
    return b;
}
__device__ __forceinline__ void xcd_barrier_complete(unsigned* bar, unsigned x, unsigned& nloc, unsigned& nx) {
    const unsigned G = gridDim.x * gridDim.y * gridDim.z;
    unsigned sum, cnt, mine, sp = 0u;
    for (;;) {
        sum = 0u; cnt = 0u; mine = 0u;
#pragma unroll
        for (unsigned j = 0; j < 16; ++j) { const unsigned c = xb_ld(&bar[XB_XCNT(j)]); sum += c; cnt += (c > 0u) ? 1u : 0u; mine = (j == x) ? c : mine; }
        if (sum == G) break;
        __builtin_amdgcn_s_sleep(1);
        if ((++sp & 255u) == 0u) { if (xb_ld(&bar[XB_TMO])) break; if (sp > XB_SPIN_CAP) { atomicAdd(&bar[XB_TMO], 1u); break; } }
    }
    nloc = mine > 0u ? mine : 1u; nx = cnt > 0u ? cnt : 1u;
}
__device__ __forceinline__ void xcd_barrier(const XcdBarrier& b) {
    asm volatile("s_waitcnt vmcnt(0)" ::: "memory");
    __syncthreads();
    if (threadIdx.x == 0) {
        unsigned* bar = b.bar;
        __builtin_amdgcn_s_waitcnt(0);
        unsigned nloc = b.st[0], nx = b.st[1];
        if (nloc == 0u) { xcd_barrier_complete(bar, b.x, nloc, nx); b.st[0] = nloc; b.st[1] = nx; }
        const unsigned old = xb_add(&bar[XB_XSUB(b.x)], 1u);
        const unsigned gen = old / nloc;
        if (old + 1u == (gen + 1u) * nloc) {
            __builtin_amdgcn_fence(__ATOMIC_RELEASE, "agent");
            asm volatile("s_waitcnt vmcnt(0)" ::: "memory");
            const unsigned og = xb_add(&bar[XB_TOP], 1u);
            const unsigned tg = og / nx;
            if (og + 1u == (tg + 1u) * nx) xb_add(&bar[XB_TOPGEN], 1u);
            else XB_SPIN(xb_ld(&bar[XB_TOPGEN]) == tg, bar);
            __builtin_amdgcn_fence(__ATOMIC_ACQUIRE, "agent");
            xb_add(&bar[XB_XGEN(b.x)], 1u);
            asm volatile("s_waitcnt vmcnt(0)" ::: "memory");
        } else {
            XB_SPIN(xb_ld(&bar[XB_XGEN(b.x)]) == gen, bar);
            __builtin_amdgcn_fence(__ATOMIC_ACQUIRE, "agent");
            asm volatile("s_waitcnt vmcnt(0)" ::: "memory");
        }
    }
    __syncthreads();
}

#ifndef PHMASK
#define PHMASK 0xFFFF
#endif
#define PH(k) if ((PHMASK >> (k)) & 1)
#ifndef REPMASK
#define REPMASK 0
#endif
#define REP(k)
__global__ void __launch_bounds__(NTHR, 2) hymba_fwd(Args a) {
    extern __shared__ __attribute__((aligned(16))) unsigned char shm[];
    LAS unsigned char* lds = (LAS unsigned char*)shm;
    cg::grid_group grid = cg::this_grid();
    int tid = threadIdx.x; const int bx = blockIdx.x, G = gridDim.x;
#define LAUNDER() asm volatile("" : "+v"(tid))
#define GSYNC() do { xcd_barrier(xb); LAUNDER(); } while (0)
    if (tid < 4) ((LAS unsigned*)(lds + 131072))[tid] = 0u;
    __syncthreads();
    const XcdBarrier xb = xcd_barrier_post((unsigned*)(a.ws + WS_BAR), (volatile LAS unsigned*)(lds + 131072));
    if (a.never) grid.sync();
    unsigned char* ws = a.ws;
    const float* MOD = (const float*)(ws + WS_MOD);
    bf16_t* H = (bf16_t*)(ws + WS_H); bf16_t* Gb = (bf16_t*)(ws + WS_G); bf16_t* X = (bf16_t*)(ws + WS_X); bf16_t* OMIX = (bf16_t*)(ws + WS_OMIX); float* PART = (float*)(ws + WS_PART);

    REP(0) {
    if (!(bx & 1)) { for (int u = bx; u < 256; u += G) ada_unit(lds, a, u, tid); }
    convert_range(lds, a, 0, (G == 256) ? CT_P0 : CT_EARLY, bx, G, tid);
    if (bx & 1) { for (int u = bx; u < 256; u += G) ada_unit(lds, a, u, tid); }
    GSYNC();
    }
    PH(1) rows_phase(a, a.in[0], false, a.in[1], false, a.in[9], 0 * D, 1 * D, true, SampleResid{nullptr, 0, 0, 0.f}, tid, lds);
    GSYNC();
    REP(2) {
    PH(2) { pg8::Gemm g{H, (const bf16_t*)(ws + WS_WUP1), MP, 2 * DFF, D}; pg8::StaticOrder S; S.init(MP, 2 * DFF, D, G, bx, 1); EpiSwiGLU E{Gb};
      pg8::gemm_phase(lds, g, S, E); }
    { int first = bx, stride = G;
      if (G == 256) { first = bx - 172; stride = 84; }
      if (first >= 0) convert_range(lds, a, CT_EARLY, CT_MID, first, stride, tid); }
    GSYNC();
    }
    REP(3) {
    PH(3) { pg8::Gemm g{Gb, (const bf16_t*)(ws + WS_WDN1), MP, D, DFF}; pg8::StaticOrder S; S.init(MP, D, DFF, G, bx, NS_DN); EpiResid<false> E{a.in[0], X, MOD + 2 * D, 0.5f, PART};
      pg8::gemm_phase(lds, g, S, E); }
    if (G == 256 && bx >= NS_DN * 8) convert_range(lds, a, CT_P0, CT_I3, bx - NS_DN * 8, 256 - NS_DN * 8, tid);
    GSYNC();
    }
    PH(4) rows_phase(a, X, true, a.in[1], false, a.in[9] + D, 3 * D, 4 * D, false, SampleResid{PART, NS_DN, 2 * D, 0.5f}, tid, lds);
    GSYNC();
    REP(5) {
    PH(5) { pg8::Gemm g{H, (const bf16_t*)(ws + WS_WIN), MP, DIN, D}; pg8::StaticOrder S; S.init(MP, DIN, D, G, bx, NS_IN);
      EpiWin E{(bf16_t*)(ws + WS_Q), (bf16_t*)(ws + WS_K), (bf16_t*)(ws + WS_V), (bf16_t*)(ws + WS_GT), (bf16_t*)(ws + WS_U), (float*)(ws + WS_LF), a.in[13], a.in[6], a.out + OUT_CP, PART};
      pg8::gemm_phase(lds, g, S, E); }
    if (G == 256 && bx >= NS_IN * 24) convert_range(lds, a, CT_I3, CT_I5, bx - NS_IN * 24, 256 - NS_IN * 24, tid);
    GSYNC();
    }
#define HGRN_SAMPLE_UNITS() do { \
        if (G == 256) { const int nmine_ = bx < 128 ? 3 : 5; for (int k_ = 0; k_ < nmine_; ++k_) { const int u_ = (k_ < 4) ? bx + 256 * k_ : bx - 128 + 768; hgrn_sample_unit(lds, a, u_, tid); } } \
        else { for (int u_ = bx; u_ < MS * NH; u_ += G) hgrn_sample_unit(lds, a, u_, tid); } } while (0)
    REP(6) {
    if (bx & 1) { HGRN_SAMPLE_UNITS(); }
    const int vbx = (G % 8 == 0) ? (bx & 7) * (G >> 3) + (bx >> 3) : bx;
    PH(6) for (int u = vbx; u < 256; u += G) hgrn_passA(lds, a, u >> 3, u & 7, tid);
    PH(14) conv_prompt_phase(lds, a, tid);
    PH(15) for (int u = bx; u < MS; u += G) conv_sample_unit(lds, a, u, tid);
    if (!(bx & 1)) { HGRN_SAMPLE_UNITS(); }
    GSYNC();
    PH(7) for (int u = vbx; u < 256; u += G) hgrn_passB(lds, a, u >> 3, u & 7, tid);
    GSYNC();
    }
    PH(8) { pg8::Gemm g{OMIX, (const bf16_t*)(ws + WS_WOUT), MP, D, D}; pg8::StaticOrder S; S.init(MP, D, D, G, bx, NS_OUT); EpiResid<true> E{X, X, MOD + 5 * D, 1.0f, PART};
      pg8::gemm_phase(lds, g, S, E); }
    if (G == 256 && bx >= NS_OUT * 8) convert_range(lds, a, CT_I5, CT2, bx - NS_OUT * 8, 256 - NS_OUT * 8, tid);
    GSYNC();
    PH(9) rows_phase(a, X, true, X + (size_t)MP * D, true, a.in[9] + 2 * D, 6 * D, 7 * D, false, SampleResid{PART, NS_OUT, 5 * D, 1.0f}, tid, lds);
    GSYNC();
    PH(10) { pg8::Gemm g{H, (const bf16_t*)(ws + WS_WUP2), MP, 2 * DFF, D}; pg8::StaticOrder S; S.init(MP, 2 * DFF, D, G, bx, 1); EpiSwiGLU E{Gb};
      pg8::gemm_phase(lds, g, S, E); }
    { int first = bx, stride = G;
      if (G == 256) { first = bx - 172; stride = 84; }
      if (first >= 0) convert_range(lds, a, CT_MID, CT_ALL, first, stride, tid); }
    GSYNC();
    PH(11) { pg8::Gemm g{Gb, (const bf16_t*)(ws + WS_WDN2), MP, D, DFF}; pg8::StaticOrder S; S.init(MP, D, DFF, G, bx, NS_DN); EpiResid<true> E{X, X, MOD + 8 * D, 0.5f, PART};
      pg8::gemm_phase(lds, g, S, E); }
    GSYNC();
    final_phase(a, SampleResid{PART, NS_DN, 8 * D, 0.5f}, tid, lds);
}

extern "C" void kernel_launch(void* const* d_in, const int* in_sizes, int n_in, void* d_out, int out_size, void* d_ws, size_t ws_size, hipStream_t stream) {
    constexpr int LDS_BYTES = 131072 + 1024;
    static int grid = 0;
    if (!grid) {
        int dev = 0, cus = 0, per_cu = 0;
        (void)hipGetDevice(&dev);
        (void)hipDeviceGetAttribute(&cus, hipDeviceAttributeMultiprocessorCount, dev);
        (void)hipFuncSetAttribute((const void*)hymba_fwd, hipFuncAttributeMaxDynamicSharedMemorySize, LDS_BYTES);
        (void)hipOccupancyMaxActiveBlocksPerMultiprocessor(&per_cu, (const void*)hymba_fwd, NTHR, LDS_BYTES);
        if (ws_size < WS_END || n_in != 23) { fprintf(stderr, "kernel_launch: ws %zu < %zu or n_in %d\n", ws_size, (size_t)WS_END, n_in); grid = -1; return; }
        grid = cus > 0 ? cus : 256;
        fprintf(stderr, "kernel_launch: cus %d per_cu %d grid %d\n", cus, per_cu, grid);
    }
    if (grid < 0) return;
    (void)hipMemsetAsync((unsigned char*)d_ws + WS_BAR, 0, 16384, stream);
    Args a{};
    for (int i = 0; i < 23; ++i) a.in[i] = (const float*)d_in[i];
    a.out = (float*)d_out; a.ws = (unsigned char*)d_ws;
    void* args[] = {&a};
    hipError_t e = hipLaunchCooperativeKernel((const void*)hymba_fwd, dim3(grid), dim3(NTHR), args, LDS_BYTES, stream);
    if (e != hipSuccess) fprintf(stderr, "kernel_launch: cooperative launch failed: %s (grid %d)\n", hipGetErrorString(e), grid);
}
```

```cpp
#include <hip/hip_runtime.h>
#include <hip/hip_cooperative_groups.h>
#include <cstdio>
namespace cg = cooperative_groups;

#define LAS __attribute__((address_space(3)))
typedef unsigned short bf16_t;
typedef short bf16x8 __attribute__((ext_vector_type(8)));
typedef float f32x4 __attribute__((ext_vector_type(4)));
typedef float f32x2 __attribute__((ext_vector_type(2)));
typedef unsigned u32x4 __attribute__((ext_vector_type(4)));
typedef unsigned u32x2 __attribute__((ext_vector_type(2)));

constexpr int D = 2048, NBATCH = 4, SEQ = 2048, MP = NBATCH * SEQ, MS = 128, MR = MP + MS, MPAD = 8448;
constexpr int DFF = 5632, DIN = 6144, DA = 1024, NH = 8, NMOD = 9 * D, CW = 31;
constexpr float EPS = 1e-6f;
constexpr int NTHR = 512;

constexpr size_t SZ_WUP = (size_t)2 * DFF * D * 2, SZ_WDN = (size_t)D * DFF * 2, SZ_WIN = (size_t)DIN * D * 2, SZ_WOUT = (size_t)D * D * 2;
constexpr size_t WS_WUP1 = 0, WS_WDN1 = WS_WUP1 + SZ_WUP, WS_WIN = WS_WDN1 + SZ_WDN, WS_WOUT = WS_WIN + SZ_WIN, WS_WUP2 = WS_WOUT + SZ_WOUT, WS_WDN2 = WS_WUP2 + SZ_WUP;
constexpr size_t WS_MOD = WS_WDN2 + SZ_WDN;
constexpr size_t WS_H = WS_MOD + (size_t)144 * NMOD * 4;
constexpr size_t WS_G = WS_H + (size_t)MPAD * D * 2;
constexpr size_t WS_X = WS_G + (size_t)MPAD * DFF * 2;
constexpr size_t WS_Q = WS_X + (size_t)MPAD * D * 4;
constexpr size_t WS_K = WS_Q + (size_t)MPAD * DA * 2;
constexpr size_t WS_V = WS_K + (size_t)MPAD * DA * 2;
constexpr size_t WS_GT = WS_V + (size_t)MPAD * DA * 2;
constexpr size_t WS_U = WS_GT + (size_t)MPAD * DA * 2;
constexpr size_t WS_LF = WS_U + (size_t)MPAD * DA * 2;
constexpr size_t WS_OMIX = WS_LF + (size_t)MPAD * DA * 4;
constexpr size_t WS_LLOC = WS_OMIX + (size_t)MPAD * D * 2;
constexpr size_t WS_DLOC = WS_LLOC + (size_t)32 * 8 * 128 * 128 * 4;
constexpr size_t WS_PART = WS_DLOC + (size_t)32 * 8 * 128 * 4;
constexpr int NS_DN = 22, NS_IN = 8, NS_OUT = 8;
constexpr size_t WS_BAR = WS_PART + (size_t)8 * 128 * DIN * 4;
constexpr size_t WS_END = WS_BAR + 16384;
static_assert((size_t)NS_DN * 128 * D * 4 <= (size_t)8 * 128 * DIN * 4, "partial buffer");

constexpr size_t OUT_Y = 0, OUT_HP = (size_t)MR * D, OUT_HS = OUT_HP + (size_t)NBATCH * NH * 128 * 128, OUT_CP = OUT_HS + (size_t)MS * NH * 128 * 128,
                 OUT_CS = OUT_CP + (size_t)NBATCH * 30 * 1024;

struct Args {
    const float* in[23];
    float* out;
    unsigned char* ws;
    int never; int pad;
};

typedef __bf16 bf16x2_t __attribute__((ext_vector_type(2)));
__device__ __forceinline__ unsigned cvt_pk_bf16(float lo, float hi) { const f32x2 v = {lo, hi}; const bf16x2_t b = __builtin_convertvector(v, bf16x2_t); return __builtin_bit_cast(unsigned, b); }
__device__ __forceinline__ float bf_lo(unsigned u) { return __uint_as_float(u << 16); }
__device__ __forceinline__ float bf_hi(unsigned u) { return __uint_as_float(u & 0xffff0000u); }
__device__ __forceinline__ float bf2f(bf16_t b) { return __uint_as_float(((unsigned)b) << 16); }
__device__ __forceinline__ bf16_t f2bf(float f) { return (bf16_t)(cvt_pk_bf16(f, 0.f) & 0xffffu); }
__device__ __forceinline__ float sigmoidf_(float x) { return __builtin_amdgcn_rcpf(1.0f + __expf(-x)); }
__device__ __forceinline__ float siluf_(float x) { return x * sigmoidf_(x); }
__device__ __forceinline__ int modrow_of(int row) { return row < MP ? (row >> 11) : (4 + row - MP); }

namespace pg8 {
constexpr int BM = 256, BK = 64, HALF = 128, HTB = HALF * BK * 2, STAGE_BYTES = 8 * HTB, NXCD = 8, WGM = 8;
__device__ __forceinline__ int lds_byte(int r, int c) { const int st = (r >> 4) * 2 + (c >> 5), rr = r & 15, cc = c & 31, ob = rr * 64 + cc * 2; return st * 1024 + (ob ^ (((ob >> 9) & 1) << 5)); }
__device__ __forceinline__ void stage_rc(int b, int& R, int& C) { const int st = b / 1024, sb = b % 1024, swz = sb ^ (((sb >> 9) & 1) << 5); R = (st >> 1) * 16 + swz / 64; C = (st & 1) * 32 + (swz % 64) / 2; }
__device__ __forceinline__ int perm32(int rho) { const int n = rho >> 4, i = rho & 15; return 8 * (i >> 2) + 4 * n + (i & 3); }

struct Unit { int pm, pn, kt0, nt, split; };
struct Gemm { const bf16_t* A; const bf16_t* Bt; int M, N, K; };

struct StaticOrder {
    int nM, nN, nwg, G, c, nt_full, nextra, nNx, ntx, nsplit;
    __device__ void init(int M, int N, int K, int G_, int c_, int nsplit_) { nM = M / BM; nN = N / BM; nwg = nM * nN; G = G_; c = c_; nt_full = K / BK; nNx = nN; nsplit = nsplit_; nextra = nNx * nsplit; ntx = nt_full / nsplit; }
    __device__ bool next(int i, Unit& u) const {
        const long L = (long)i * G + c;
        if (L >= nwg) { const int e = (int)(L - nwg); if (e >= nextra) return false; const int sp = e / nNx; u.pm = 32; u.pn = e - sp * nNx; u.kt0 = sp * ntx; u.nt = ntx; u.split = nsplit > 1 ? sp : -1; return true; }
        int wgid = (int)L; { const int q = nwg / NXCD, r = nwg % NXCD, xcd = wgid % NXCD, off = wgid / NXCD; wgid = (xcd < r ? xcd * (q + 1) : r * (q + 1) + (xcd - r) * q) + off; }
        const int nig = WGM * nN, gid = wgid / nig, fm = gid * WGM, gsz = (nM - fm) < WGM ? (nM - fm) : WGM;
        u.pm = fm + ((wgid % nig) % gsz); u.pn = (wgid % nig) / gsz; u.kt0 = 0; u.nt = nt_full; u.split = -1; return true;
    }
};

template <class Epi, class Sched>
__device__ __forceinline__ void gemm_phase(LAS unsigned char* lds, const Gemm g, const Sched& S, const Epi& E) {
    int tid = threadIdx.x; asm volatile("" : "+v"(tid));
    const int wid = __builtin_amdgcn_readfirstlane(tid >> 6), lane = tid & 63, wr = wid >> 2, wc = wid & 3, fr = lane & 15, fq = lane >> 4;
    const int K = g.K;
    unsigned voffA[2], voffB[2];
#pragma unroll
    for (int i = 0; i < 2; ++i) { int R, C; stage_rc(tid * 16 + i * 8192, R, C); const int Rb = Epi::PERM ? ((R & ~31) + perm32(R & 31)) : R;
        voffA[i] = (unsigned)(R * K + C) * 2u; voffB[i] = (unsigned)(Rb * K + C) * 2u; }
    const size_t kstep = (size_t)(BK * 2);
    const size_t hstep = (size_t)HALF * K * 2;
    const size_t tstep = 2 * hstep;
    const unsigned ldsw = (unsigned)wid * 1024u;
    const int aoff = lds_byte(wr * 64 + fr, fq * 8), boff = lds_byte(wc * 32 + fr, fq * 8);
#define PG8_SA(b, h) (((b) * 2 + (h)) * HTB)
#define PG8_SB(b, h) ((4 + (b) * 2 + (h)) * HTB)
#define PG8_STAGE(bufoff, gbase, voff) do { _Pragma("unroll") for (int _i = 0; _i < 2; ++_i) \
        __builtin_amdgcn_global_load_lds((const unsigned*)((const char*)(gbase) + (voff)[_i]), (LAS unsigned*)(lds + (bufoff) + ldsw + _i * 8192), 16, 0, 0); } while (0)
#define PG8_LDA(dst, b, h) do { _Pragma("unroll") for (int m = 0; m < 4; ++m) _Pragma("unroll") for (int k = 0; k < 2; ++k) dst[m][k] = *(const LAS bf16x8*)(lds + PG8_SA(b, h) + aoff + m * 2048 + k * 1024); } while (0)
#define PG8_LDB(dst, b, h) do { _Pragma("unroll") for (int n = 0; n < 2; ++n) _Pragma("unroll") for (int k = 0; k < 2; ++k) dst[n][k] = *(const LAS bf16x8*)(lds + PG8_SB(b, h) + boff + n * 2048 + k * 1024); } while (0)
#define PG8_MMA(ai, bj, At, Bt) do { __builtin_amdgcn_s_setprio(1); _Pragma("unroll") for (int m = 0; m < 4; ++m) _Pragma("unroll") for (int n = 0; n < 2; ++n) _Pragma("unroll") for (int k = 0; k < 2; ++k) \
        acc[ai][bj][m][n] = __builtin_amdgcn_mfma_f32_16x16x32_bf16(Bt[n][k], At[m][k], acc[ai][bj][m][n], 0, 0, 0); __builtin_amdgcn_s_setprio(0); } while (0)
#define PG8_WAIT_V(n) asm volatile("s_waitcnt vmcnt(" #n ")" ::: "memory")
#define PG8_WAIT_L(n) asm volatile("s_waitcnt lgkmcnt(" #n ")" ::: "memory")
#define PG8_BAR __builtin_amdgcn_s_barrier()
#define PG8_SCHED __builtin_amdgcn_sched_barrier(0)
    Unit cur, nxt; int ui = 0;
    if (!S.next(0, cur)) return;
    f32x4 acc[2][2][4][2];
#pragma unroll
    for (int a = 0; a < 2; ++a)
#pragma unroll
        for (int b = 0; b < 2; ++b)
#pragma unroll
            for (int m = 0; m < 4; ++m)
#pragma unroll
                for (int n = 0; n < 2; ++n) acc[a][b][m][n] = (f32x4){0.f, 0.f, 0.f, 0.f};
    bf16x8 At[4][2], B0[2][2], B1[2][2];
    const char* cA = (const char*)g.A + (size_t)cur.pm * tstep + (size_t)cur.kt0 * kstep; const char* cB = (const char*)g.Bt + (size_t)cur.pn * tstep + (size_t)cur.kt0 * kstep;
    PG8_STAGE(PG8_SB(0, 0), cB, voffB); PG8_STAGE(PG8_SA(0, 0), cA, voffA); PG8_STAGE(PG8_SB(0, 1), cB + hstep, voffB); PG8_STAGE(PG8_SA(0, 1), cA + hstep, voffA);
    if (wr == 1) PG8_BAR;
    PG8_WAIT_V(4); PG8_BAR;
    PG8_STAGE(PG8_SB(1, 0), cB + kstep, voffB); PG8_STAGE(PG8_SA(1, 0), cA + kstep, voffA); PG8_STAGE(PG8_SB(1, 1), cB + hstep + kstep, voffB);
    PG8_WAIT_V(6); PG8_BAR;
    for (;;) {
        const bool has_next = S.next(ui + 1, nxt);
        const char* nA = has_next ? (const char*)g.A + (size_t)nxt.pm * tstep + (size_t)nxt.kt0 * kstep : cA; const char* nB = has_next ? (const char*)g.Bt + (size_t)nxt.pn * tstep + (size_t)nxt.kt0 * kstep : cB;
        const int nt = cur.nt;
        for (int t = 0; t < nt; t += 2) {
            const bool last = (t == nt - 2);
            const char* a1 = cA + (size_t)(t + 1) * kstep;
            const char* a2 = last ? nA : cA + (size_t)(t + 2) * kstep; const char* b2 = last ? nB : cB + (size_t)(t + 2) * kstep;
            const char* a3 = a2 + kstep; const char* b3 = b2 + kstep;
            PG8_LDB(B0, 0, 0); PG8_SCHED; PG8_LDA(At, 0, 0); PG8_STAGE(PG8_SA(1, 1), a1 + hstep, voffA);
            PG8_WAIT_L(8); PG8_BAR; PG8_WAIT_L(0); PG8_MMA(0, 0, At, B0); PG8_BAR; PG8_SCHED;
            PG8_LDB(B1, 0, 1); PG8_STAGE(PG8_SB(0, 0), b2, voffB);
            PG8_BAR; PG8_WAIT_L(0); PG8_MMA(0, 1, At, B1); PG8_BAR;
            PG8_LDA(At, 0, 1); PG8_STAGE(PG8_SA(0, 0), a2, voffA);
            PG8_BAR; PG8_WAIT_L(0); PG8_MMA(1, 0, At, B0); PG8_BAR; PG8_SCHED;
            PG8_STAGE(PG8_SB(0, 1), b2 + hstep, voffB);
            PG8_WAIT_V(6); PG8_BAR; PG8_MMA(1, 1, At, B1); PG8_BAR;
            PG8_LDB(B0, 1, 0); PG8_SCHED; PG8_LDA(At, 1, 0); PG8_STAGE(PG8_SA(0, 1), a2 + hstep, voffA);
            PG8_WAIT_L(8); PG8_BAR; PG8_WAIT_L(0); PG8_MMA(0, 0, At, B0); PG8_BAR; PG8_SCHED;
            PG8_LDB(B1, 1, 1); PG8_STAGE(PG8_SB(1, 0), b3, voffB);
            PG8_BAR; PG8_WAIT_L(0); PG8_MMA(0, 1, At, B1); PG8_BAR;
            PG8_LDA(At, 1, 1); PG8_STAGE(PG8_SA(1, 0), a3, voffA);
            PG8_BAR; PG8_WAIT_L(0); PG8_MMA(1, 0, At, B0); PG8_BAR; PG8_SCHED;
            PG8_STAGE(PG8_SB(1, 1), b3 + hstep, voffB);
            PG8_WAIT_V(6); PG8_BAR; PG8_MMA(1, 1, At, B1); PG8_BAR;
        }
        E(acc, cur, wr, wc, fr, fq);
        if (!has_next) break;
#pragma unroll
        for (int a = 0; a < 2; ++a)
#pragma unroll
            for (int b = 0; b < 2; ++b)
#pragma unroll
                for (int m = 0; m < 4; ++m)
#pragma unroll
                    for (int n = 0; n < 2; ++n) acc[a][b][m][n] = (f32x4){0.f, 0.f, 0.f, 0.f};
        cur = nxt; cA = nA; cB = nB; ++ui;
    }
    PG8_WAIT_V(0);
    if (wr == 0) PG8_BAR;
    PG8_BAR;
#undef PG8_SA
#undef PG8_SB
#undef PG8_STAGE
#undef PG8_LDA
#undef PG8_LDB
#undef PG8_MMA
#undef PG8_WAIT_V
#undef PG8_WAIT_L
#undef PG8_BAR
#undef PG8_SCHED
}
}

struct EpiSwiGLU {
    static constexpr bool PERM = true;
    bf16_t* O;
    __device__ __forceinline__ void operator()(const f32x4 (&acc)[2][2][4][2], const pg8::Unit& u, int wr, int wc, int fr, int fq) const {
        const int row0 = u.pm * 256 + wr * 64 + fr, col0 = u.pn * 128 + wc * 32 + 8 * fq;
#pragma unroll
        for (int ai = 0; ai < 2; ++ai)
#pragma unroll
            for (int m = 0; m < 4; ++m) {
                bf16_t* rowp = O + (size_t)(row0 + ai * 128 + m * 16) * DFF + col0;
                const f32x4 a0 = acc[ai][0][m][0], a1 = acc[ai][0][m][1], b0 = acc[ai][1][m][0], b1 = acc[ai][1][m][1];
                u32x4 w;
                w.x = cvt_pk_bf16(siluf_(a0[0]) * b0[0], siluf_(a0[1]) * b0[1]); w.y = cvt_pk_bf16(siluf_(a0[2]) * b0[2], siluf_(a0[3]) * b0[3]);
                w.z = cvt_pk_bf16(siluf_(a1[0]) * b1[0], siluf_(a1[1]) * b1[1]); w.w = cvt_pk_bf16(siluf_(a1[2]) * b1[2], siluf_(a1[3]) * b1[3]);
                *(u32x4*)rowp = w;
            }
    }
};
template <bool BASE_BF16>
struct EpiResid {
    static constexpr bool PERM = false;
    const void* base; bf16_t* X; const float* gate; float scale; float* part;
    __device__ __forceinline__ void operator()(const f32x4 (&acc)[2][2][4][2], const pg8::Unit& u, int wr, int wc, int fr, int fq) const {
        const int col0 = u.pn * 256 + wc * 32 + 4 * fq;
        if (u.split >= 0) {
            float* pp = part + (size_t)u.split * 128 * D;
#pragma unroll
            for (int m = 0; m < 4; ++m) { const int r = wr * 64 + m * 16 + fr;
#pragma unroll
                for (int bj = 0; bj < 2; ++bj)
#pragma unroll
                    for (int n = 0; n < 2; ++n) *(f32x4*)(pp + (size_t)r * D + col0 + bj * 128 + n * 16) = acc[0][bj][m][n]; }
            return;
        }
        const int row0 = u.pm * 256 + wr * 64 + fr;
        const float* gp = gate + (size_t)(u.pm >> 3) * NMOD;
        f32x4 gv[2][2];
#pragma unroll
        for (int bj = 0; bj < 2; ++bj)
#pragma unroll
            for (int n = 0; n < 2; ++n) gv[bj][n] = *(const f32x4*)(gp + col0 + bj * 128 + n * 16);
#pragma unroll
        for (int bj = 0; bj < 2; ++bj)
#pragma unroll
            for (int n = 0; n < 2; ++n) gv[bj][n] *= scale;
#pragma unroll
        for (int ai = 0; ai < 2; ++ai)
#pragma unroll
            for (int mp = 0; mp < 2; ++mp) {
                f32x4 bv[2][2][2];
#pragma unroll
                for (int mm = 0; mm < 2; ++mm) {
                    const size_t ro = (size_t)(row0 + ai * 128 + (2 * mp + mm) * 16) * D;
#pragma unroll
                    for (int bj = 0; bj < 2; ++bj)
#pragma unroll
                        for (int n = 0; n < 2; ++n) {
                            const size_t o = ro + col0 + bj * 128 + n * 16;
                            if (BASE_BF16) { const u32x2 w = *(const u32x2*)((const bf16_t*)base + o); bv[mm][bj][n] = (f32x4){bf_lo(w.x), bf_hi(w.x), bf_lo(w.y), bf_hi(w.y)}; }
                            else bv[mm][bj][n] = *(const f32x4*)((const float*)base + o);
                        }
                }
#pragma unroll
                for (int mm = 0; mm < 2; ++mm) {
                    const size_t ro = (size_t)(row0 + ai * 128 + (2 * mp + mm) * 16) * D;
#pragma unroll
                    for (int bj = 0; bj < 2; ++bj)
#pragma unroll
                        for (int n = 0; n < 2; ++n) { const f32x4 v = bv[mm][bj][n] + gv[bj][n] * acc[ai][bj][2 * mp + mm][n];
                            *(u32x2*)(X + ro + col0 + bj * 128 + n * 16) = (u32x2){cvt_pk_bf16(v[0], v[1]), cvt_pk_bf16(v[2], v[3])}; }
                }
            }
    }
};
struct EpiWin {
    static constexpr bool PERM = true;
    bf16_t *Q, *Kb, *V, *GT, *U; float* LF; const float* b_in; const float* lbl; float* ncp; float* part;
    __device__ __forceinline__ void operator()(const f32x4 (&acc)[2][2][4][2], const pg8::Unit& u, int wr, int wc, int fr, int fq) const {
        const int row0 = u.pm * 256 + wr * 64 + fr, cl = wc * 32 + 8 * fq;
        if (u.split >= 0) {
            float* pp = part + (size_t)u.split * 128 * DIN + u.pn * 256 + cl;
#pragma unroll
            for (int m = 0; m < 4; ++m) { const int r = wr * 64 + m * 16 + fr;
#pragma unroll
                for (int bj = 0; bj < 2; ++bj)
#pragma unroll
                    for (int n = 0; n < 2; ++n) *(f32x4*)(pp + (size_t)r * DIN + bj * 128 + 4 * n) = acc[0][bj][m][n]; }
            return;
        }
        if (u.pn < 16) {
            const int region = u.pn >> 2;
#pragma unroll
            for (int bj = 0; bj < 2; ++bj) {
                const int colz = u.pn * 256 + bj * 128 + cl, c1k = colz & 1023;
                const f32x4 bi0 = *(const f32x4*)(b_in + colz), bi1 = *(const f32x4*)(b_in + colz + 4);
                float oml[8];
                if (region == 1) {
#pragma unroll
                    for (int e = 0; e < 8; ++e) { const float l0 = lbl[c1k + e], l1 = lbl[1024 + c1k + e]; oml[e] = 1.0f - 1.0f / (1.0f + __expf(l1 - l0)); }
                }
#pragma unroll
                for (int ai = 0; ai < 2; ++ai)
#pragma unroll
                    for (int m = 0; m < 4; ++m) {
                        const size_t row = (size_t)(row0 + ai * 128 + m * 16);
                        float z[8];
#pragma unroll
                        for (int e = 0; e < 4; ++e) { z[e] = acc[ai][bj][m][0][e] + bi0[e]; z[4 + e] = acc[ai][bj][m][1][e] + bi1[e]; }
                        if (region == 1) {
                            float kk[8], lf[8];
#pragma unroll
                            for (int e = 0; e < 8; ++e) { kk[e] = oml[e] * sigmoidf_(-z[e]); lf[e] = __logf(1.0f - kk[e]); }
                            *(f32x4*)(LF + row * DA + c1k) = (f32x4){lf[0], lf[1], lf[2], lf[3]};
                            *(f32x4*)(LF + row * DA + c1k + 4) = (f32x4){lf[4], lf[5], lf[6], lf[7]};
                            u32x4 w; w.x = cvt_pk_bf16(kk[0], kk[1]); w.y = cvt_pk_bf16(kk[2], kk[3]); w.z = cvt_pk_bf16(kk[4], kk[5]); w.w = cvt_pk_bf16(kk[6], kk[7]);
                            *(u32x4*)(Kb + row * DA + c1k) = w;
                        } else {
                            if (region != 2) {
#pragma unroll
                                for (int e = 0; e < 8; ++e) z[e] = siluf_(z[e]);
                            }
                            u32x4 w; w.x = cvt_pk_bf16(z[0], z[1]); w.y = cvt_pk_bf16(z[2], z[3]); w.z = cvt_pk_bf16(z[4], z[5]); w.w = cvt_pk_bf16(z[6], z[7]);
                            *(u32x4*)(Q + (size_t)region * ((size_t)MPAD * DA) + row * DA + c1k) = w;
                        }
                    }
            }
        } else {
            const int cu = (u.pn - 16) * 128 + cl;
            const f32x4 ba0 = *(const f32x4*)(b_in + 4096 + cu), ba1 = *(const f32x4*)(b_in + 4096 + cu + 4);
            const f32x4 bb0 = *(const f32x4*)(b_in + 5120 + cu), bb1 = *(const f32x4*)(b_in + 5120 + cu + 4);
#pragma unroll
            for (int ai = 0; ai < 2; ++ai)
#pragma unroll
                for (int m = 0; m < 4; ++m) {
                    const int row = row0 + ai * 128 + m * 16;
                    float uu[8];
#pragma unroll
                    for (int e = 0; e < 4; ++e) {
                        uu[e] = (acc[ai][0][m][0][e] + ba0[e]) * sigmoidf_(acc[ai][1][m][0][e] + bb0[e]);
                        uu[4 + e] = (acc[ai][0][m][1][e] + ba1[e]) * sigmoidf_(acc[ai][1][m][1][e] + bb1[e]);
                    }
                    u32x4 w; w.x = cvt_pk_bf16(uu[0], uu[1]); w.y = cvt_pk_bf16(uu[2], uu[3]); w.z = cvt_pk_bf16(uu[4], uu[5]); w.w = cvt_pk_bf16(uu[6], uu[7]);
                    *(u32x4*)(U + (size_t)row * DA + cu) = w;
                    const int tt = row & (SEQ - 1);
                    if (tt >= SEQ - 30) { float* tail = ncp + ((size_t)(row >> 11) * 30 + (tt - (SEQ - 30))) * 1024 + cu;
                        *(f32x4*)tail = (f32x4){uu[0], uu[1], uu[2], uu[3]}; *(f32x4*)(tail + 4) = (f32x4){uu[4], uu[5], uu[6], uu[7]}; }
                }
        }
    }
};

#define LDSBAR2() asm volatile("s_waitcnt lgkmcnt(0)\n\ts_barrier" ::: "memory")
__device__ __forceinline__ int src_col(int mode, int n) {
    if (mode == 1) { const int pn = n >> 8, bj = (n >> 7) & 1, r = n & 127; return bj * DFF + pn * 128 + r; }
    if (mode == 2) { if (n < 4096) return n; const int t = (n - 4096) >> 8, bj = (n >> 7) & 1, r = n & 127; return 4096 + bj * 1024 + t * 128 + r; }
    return n;
}
constexpr int CT_UP = (D / 128) * (2 * DFF / 128), CT_DN = (DFF / 128) * (D / 128), CT_IN = (D / 128) * (DIN / 128), CT_OUT = (D / 128) * (D / 128);
constexpr int CT0 = CT_UP, CT1 = CT0 + CT_DN, CT2 = CT1 + CT_UP, CT3 = CT2 + CT_IN, CT4 = CT3 + CT_OUT, CT_ALL = CT4 + CT_DN;
constexpr int CT_EARLY = CT2, CT_MID = CT4;
constexpr int CT_P0 = CT2 - 672, CT_I3 = CT_P0 + 160, CT_I5 = CT_I3 + 128;
struct ConvTile { const float* src; bf16_t* dst; int Ks, Ns, kt, nt, col0; };
__device__ __forceinline__ ConvTile conv_tile_of(const Args& a, int t) {
    ConvTile c; int mode, ntn, tl; unsigned char* ws = a.ws;
    if (t < CT0)      { tl = t;       c.src = a.in[10]; c.dst = (bf16_t*)(ws + WS_WUP1); c.Ks = D;   c.Ns = 2 * DFF; mode = 1; }
    else if (t < CT1) { tl = t - CT0; c.src = a.in[11]; c.dst = (bf16_t*)(ws + WS_WDN1); c.Ks = DFF; c.Ns = D;       mode = 0; }
    else if (t < CT2) { tl = t - CT1; c.src = a.in[20]; c.dst = (bf16_t*)(ws + WS_WUP2); c.Ks = D;   c.Ns = 2 * DFF; mode = 1; }
    else if (t < CT3) { tl = t - CT2; c.src = a.in[12]; c.dst = (bf16_t*)(ws + WS_WIN);  c.Ks = D;   c.Ns = DIN;     mode = 2; }
    else if (t < CT4) { tl = t - CT3; c.src = a.in[19]; c.dst = (bf16_t*)(ws + WS_WOUT); c.Ks = D;   c.Ns = D;       mode = 0; }
    else              { tl = t - CT4; c.src = a.in[21]; c.dst = (bf16_t*)(ws + WS_WDN2); c.Ks = DFF; c.Ns = D;       mode = 0; }
    ntn = c.Ns / 128; c.kt = tl / ntn; c.nt = tl - c.kt * ntn; c.col0 = src_col(mode, c.nt * 128);
    return c;
}
__device__ __forceinline__ void conv_load(const Args& a, int t, int tid, f32x4 (&r)[8]) {
    const ConvTile c = conv_tile_of(a, t);
    const float* base = c.src + (size_t)(c.kt * 128) * c.Ns + c.col0;
#pragma unroll
    for (int i = 0; i < 8; ++i) { const int idx = tid + NTHR * i; const int c4 = (idx & 7) + 8 * ((idx >> 5) & 3), kk = ((idx >> 3) & 3) + 4 * (idx >> 7);
        r[i] = __builtin_nontemporal_load((const f32x4*)(base + (size_t)kk * c.Ns + 4 * c4)); }
}
__device__ __forceinline__ void conv_emit(LAS float* T, const Args& a, int t, int tid, const f32x4 (&r)[8], bool more, int tnext, f32x4 (&rn)[8]) {
    const int w = tid >> 6, lane = tid & 63, nl = lane >> 3, kc = lane & 7;
#pragma unroll
    for (int i = 0; i < 8; ++i) { const int idx = tid + NTHR * i; const int c4 = (idx & 7) + 8 * ((idx >> 5) & 3), kk = ((idx >> 3) & 3) + 4 * (idx >> 7);
        LAS float* p = T + kk * 129 + 4 * c4; p[0] = r[i][0]; p[1] = r[i][1]; p[2] = r[i][2]; p[3] = r[i][3]; }
    LDSBAR2();
    if (more) conv_load(a, tnext, tid, rn);
    const ConvTile c = conv_tile_of(a, t);
#pragma unroll
    for (int np = 0; np < 2; ++np) {
        const int n = 64 * np + 8 * w + nl;
#pragma unroll
        for (int kp = 0; kp < 2; ++kp) {
            const int k = 64 * kp + 8 * kc;
            float v[8];
#pragma unroll
            for (int e = 0; e < 8; ++e) v[e] = T[(k + e) * 129 + n];
            u32x4 o; o.x = cvt_pk_bf16(v[0], v[1]); o.y = cvt_pk_bf16(v[2], v[3]); o.z = cvt_pk_bf16(v[4], v[5]); o.w = cvt_pk_bf16(v[6], v[7]);
            *(u32x4*)(c.dst + (size_t)(c.nt * 128 + n) * c.Ks + c.kt * 128 + k) = o;
        }
    }
    LDSBAR2();
}
__device__ __forceinline__ void convert_range(LAS unsigned char* lds, const Args& a, int t0, int t1, int first, int G, int tid) {
    LAS float* T = (LAS float*)lds;
    if (t0 + first >= t1) return;
    const int n_my = (t1 - t0 - first + G - 1) / G;
    const int tlast = t0 + first + (n_my - 1) * G;
    f32x4 r0[8], r1[8];
    conv_load(a, t0 + first, tid, r0);
    conv_load(a, min(t0 + first + G, tlast), tid, r1);
#pragma unroll 1
    for (int s2 = 0; s2 + 1 < n_my; s2 += 2) {
        const int tA = t0 + first + s2 * G;
        conv_emit(T, a, tA, tid, r0, true, min(tA + 2 * G, tlast), r0);
        conv_emit(T, a, tA + G, tid, r1, true, min(tA + 3 * G, tlast), r1);
    }
    if (n_my & 1) conv_emit(T, a, tlast, tid, r0, false, tlast, r0);
    __syncthreads();
}

__device__ __forceinline__ bf16x8 silu_pack8v(const f32x4 x0, const f32x4 x1) {
    u32x4 q; q.x = cvt_pk_bf16(siluf_(x0[0]), siluf_(x0[1])); q.y = cvt_pk_bf16(siluf_(x0[2]), siluf_(x0[3])); q.z = cvt_pk_bf16(siluf_(x1[0]), siluf_(x1[1])); q.w = cvt_pk_bf16(siluf_(x1[2]), siluf_(x1[3]));
    return __builtin_bit_cast(bf16x8, q);
}
__device__ __forceinline__ bf16x8 silu_pack8(const float* p) {
    const f32x4 x0 = *(const f32x4*)p, x1 = *(const f32x4*)(p + 4);
    u32x4 q; q.x = cvt_pk_bf16(siluf_(x0[0]), siluf_(x0[1])); q.y = cvt_pk_bf16(siluf_(x0[2]), siluf_(x0[3])); q.z = cvt_pk_bf16(siluf_(x1[0]), siluf_(x1[1])); q.w = cvt_pk_bf16(siluf_(x1[2]), siluf_(x1[3]));
    return __builtin_bit_cast(bf16x8, q);
}
__device__ __forceinline__ void ada_unit(LAS unsigned char* lds, const Args& a, int unit, int tid) {
    constexpr int NC = 72, PITCH = 136;
    LAS bf16_t* Bt = (LAS bf16_t*)lds;
    const float* W = a.in[7]; const float* bada = a.in[8]; const float* cp = a.in[4]; const float* cs = a.in[5];
    float* MOD = (float*)(a.ws + WS_MOD);
    const int w = tid >> 6, lane = tid & 63, fr = lane & 15, fq = lane >> 4;
    const int n0 = unit * NC;
    f32x4 acc[2][5];
#pragma unroll
    for (int mb = 0; mb < 2; ++mb)
#pragma unroll
        for (int nb = 0; nb < 5; ++nb) acc[mb][nb] = (f32x4){0.f, 0.f, 0.f, 0.f};
    const int r0 = 16 * w + fr, r1 = 128 + fr;
    const float* ap0 = (r0 < 4) ? cp + (size_t)r0 * D : cs + (size_t)(r0 - 4) * D;
    const float* ap1 = cs + (size_t)((r1 < 132 ? r1 : 131) - 4) * D;
    const bool has1 = (w == 0);
    constexpr int FP = 76;
    LAS float* F = (LAS float*)(lds + 32768);
    f32x4 r[5];
#pragma unroll
    for (int i = 0; i < 5; ++i) { const int idx = min(tid + NTHR * i, 128 * 18 - 1); const int kk = idx / 18, c4 = idx % 18;
        r[i] = __builtin_nontemporal_load((const f32x4*)(W + (size_t)kk * NMOD + n0 + 4 * c4)); }
    f32x4 xa[4][2], xb[4][2];
#define ADA_LOADA(KC) do { _Pragma("unroll") for (int ks = 0; ks < 4; ++ks) { const int k_ = (KC) + 32 * ks + 8 * fq; \
        xa[ks][0] = *(const f32x4*)(ap0 + k_); xa[ks][1] = *(const f32x4*)(ap0 + k_ + 4); xb[ks][0] = *(const f32x4*)(ap1 + k_); xb[ks][1] = *(const f32x4*)(ap1 + k_ + 4); } } while (0)
    ADA_LOADA(0);
#pragma unroll 1
    for (int kc0 = 0; kc0 < D; kc0 += 128) {
#pragma unroll
        for (int i = 0; i < 5; ++i) { const int idx = tid + NTHR * i; if (idx < 128 * 18) { const int kk = idx / 18, c4 = idx % 18; *(LAS f32x4*)(F + kk * FP + 4 * c4) = r[i]; } }
        LDSBAR2();
        { const int kn = min(kc0 + 128, D - 128);
#pragma unroll
          for (int i = 0; i < 5; ++i) { const int idx = min(tid + NTHR * i, 128 * 18 - 1); const int kk = idx / 18, c4 = idx % 18;
              r[i] = __builtin_nontemporal_load((const f32x4*)(W + (size_t)(kn + kk) * NMOD + n0 + 4 * c4)); } }
#pragma unroll
        for (int q = 0; q < 3; ++q) { const int it = tid + NTHR * q; if (it < 16 * NC) { const int kg = it / NC, n = it - kg * NC;
            float v[8];
#pragma unroll
            for (int e = 0; e < 8; ++e) v[e] = F[(8 * kg + e) * FP + n];
            *(LAS u32x4*)(Bt + n * PITCH + 8 * kg) = (u32x4){cvt_pk_bf16(v[0], v[1]), cvt_pk_bf16(v[2], v[3]), cvt_pk_bf16(v[4], v[5]), cvt_pk_bf16(v[6], v[7])}; } }
        LDSBAR2();
        bf16x8 A0[4], A1[4];
#pragma unroll
        for (int ks = 0; ks < 4; ++ks) {
            A0[ks] = silu_pack8v(xa[ks][0], xa[ks][1]);
            A1[ks] = (bf16x8){0, 0, 0, 0, 0, 0, 0, 0};
            if (has1) { const bf16x8 t1 = silu_pack8v(xb[ks][0], xb[ks][1]); if (fr < 4) A1[ks] = t1; }
        }
        ADA_LOADA(min(kc0 + 128, D - 128));
#pragma unroll
        for (int ks = 0; ks < 4; ++ks) {
#pragma unroll
            for (int nb = 0; nb < 5; ++nb) {
                const bf16x8 B = *(const LAS bf16x8*)(Bt + (16 * nb + fr) * PITCH + 32 * ks + 8 * fq);
                acc[0][nb] = __builtin_amdgcn_mfma_f32_16x16x32_bf16(A0[ks], B, acc[0][nb], 0, 0, 0);
                if (has1) acc[1][nb] = __builtin_amdgcn_mfma_f32_16x16x32_bf16(A1[ks], B, acc[1][nb], 0, 0, 0);
            }
        }
        LDSBAR2();
    }
#undef ADA_LOADA
    __syncthreads();
    float bv[5];
#pragma unroll
    for (int nb = 0; nb < 5; ++nb) { const int cl = 16 * nb + fr; bv[nb] = bada[n0 + (cl < NC ? cl : 0)]; }
#pragma unroll
    for (int mb = 0; mb < 2; ++mb) {
        if (mb == 1 && !has1) continue;
#pragma unroll
        for (int nb = 0; nb < 5; ++nb) {
            const int cl = 16 * nb + fr;
            if (cl < NC) {
#pragma unroll
                for (int j = 0; j < 4; ++j) { const int row = (mb == 0 ? 16 * w : 128) + 4 * fq + j; if (row < 132) MOD[(size_t)row * NMOD + n0 + cl] = acc[mb][nb][j] + bv[nb]; }
            }
        }
    }
}

struct SampleResid { const float* part; int nsplit; int gate_off; float rscale; };
__device__ __forceinline__ void load_row(const Args& a, int row, const void* src_p, bool p_bf16, const void* src_s, bool s_bf16, const SampleResid& sr, int lane, f32x4 (&x)[8]) {
    const bool isp = row < MP; const bool bf = isp ? p_bf16 : s_bf16;
    const size_t ro = (size_t)(isp ? row : row - MP) * D; const void* src = isp ? src_p : src_s;
    if (bf) {
#pragma unroll
        for (int i = 0; i < 8; ++i) { const u32x2 w = *(const u32x2*)((const bf16_t*)src + ro + 256 * i + 4 * lane); x[i] = (f32x4){bf_lo(w.x), bf_hi(w.x), bf_lo(w.y), bf_hi(w.y)}; }
    } else {
#pragma unroll
        for (int i = 0; i < 8; ++i) x[i] = *(const f32x4*)((const float*)src + ro + 256 * i + 4 * lane);
    }
    if (row >= MP && sr.part) {
        const float* gp = (const float*)(a.ws + WS_MOD) + (size_t)modrow_of(row) * NMOD + sr.gate_off;
        bf16_t* Xr = (bf16_t*)(a.ws + WS_X) + (size_t)row * D;
        f32x4 p[8], gv[8];
#pragma unroll
        for (int i = 0; i < 8; ++i) { p[i] = (f32x4){0.f, 0.f, 0.f, 0.f}; gv[i] = *(const f32x4*)(gp + 256 * i + 4 * lane); }
        const float* pr = sr.part + (size_t)(row - MP) * D + 4 * lane;
#pragma unroll 2
        for (int sp = 0; sp < sr.nsplit; ++sp) {
            f32x4 t[8];
#pragma unroll
            for (int i = 0; i < 8; ++i) t[i] = *(const f32x4*)(pr + 256 * i);
#pragma unroll
            for (int i = 0; i < 8; ++i) p[i] += t[i];
            pr += (size_t)128 * D;
        }
#pragma unroll
        for (int i = 0; i < 8; ++i) { x[i] += sr.rscale * gv[i] * p[i]; *(u32x2*)(Xr + 256 * i + 4 * lane) = (u32x2){cvt_pk_bf16(x[i][0], x[i][1]), cvt_pk_bf16(x[i][2], x[i][3])}; }
    }
}
__device__ __forceinline__ float sample_row(LAS float* red, const Args& a, int si, const void* src_s, bool s_bf16, const SampleResid& sr, int wave, int lane, f32x4& x) {
    const int c = 256 * wave + 4 * lane; const int row = MP + si;
    if (s_bf16) { const u32x2 w = *(const u32x2*)((const bf16_t*)src_s + (size_t)si * D + c); x = (f32x4){bf_lo(w.x), bf_hi(w.x), bf_lo(w.y), bf_hi(w.y)}; }
    else x = *(const f32x4*)((const float*)src_s + (size_t)si * D + c);
    if (sr.part) {
        const f32x4 gv = *(const f32x4*)((const float*)(a.ws + WS_MOD) + (size_t)modrow_of(row) * NMOD + sr.gate_off + c);
        const float* pr = sr.part + (size_t)si * D + c;
        f32x4 p = (f32x4){0.f, 0.f, 0.f, 0.f};
#pragma unroll 8
        for (int sp = 0; sp < sr.nsplit; ++sp) p += *(const f32x4*)(pr + (size_t)sp * 128 * D);
        x += sr.rscale * gv * p;
        *(u32x2*)((bf16_t*)(a.ws + WS_X) + (size_t)row * D + c) = (u32x2){cvt_pk_bf16(x[0], x[1]), cvt_pk_bf16(x[2], x[3])};
    }
    float ss = x[0] * x[0] + x[1] * x[1] + x[2] * x[2] + x[3] * x[3];
#pragma unroll
    for (int o = 32; o >= 1; o >>= 1) ss += __shfl_xor(ss, o);
    __syncthreads();
    if (lane == 0) red[wave] = ss;
    __syncthreads();
    float tot = 0.f;
#pragma unroll
    for (int w8 = 0; w8 < 8; ++w8) tot += red[w8];
    return rsqrtf(tot * (1.0f / D) + EPS);
}
__device__ __forceinline__ void rows_phase(const Args& a, const void* src_p, bool p_bf16, const void* src_s, bool s_bf16, const float* g, int sh_off, int sc_off, bool zero_pad, const SampleResid sr, int tid, LAS unsigned char* lds) {
    const float* MOD = (const float*)(a.ws + WS_MOD);
    bf16_t* H = (bf16_t*)(a.ws + WS_H);
    const int lane = tid & 63, gw = blockIdx.x * 8 + (tid >> 6), nw = gridDim.x * 8;
    if (zero_pad) for (int row = MR + gw; row < MPAD; row += nw) {
#pragma unroll
        for (int i = 0; i < 8; ++i) *(u32x2*)(H + (size_t)row * D + 256 * i + 4 * lane) = (u32x2){0u, 0u};
    }
    for (int si = blockIdx.x; si < MS; si += gridDim.x) {
        const int wave = tid >> 6, c = 256 * wave + 4 * lane, row = MP + si;
        f32x4 x;
        const float rstd = sample_row((LAS float*)lds, a, si, src_s, s_bf16, sr, wave, lane, x);
        const float* mp = MOD + (size_t)modrow_of(row) * NMOD;
        const f32x4 gv = *(const f32x4*)(g + c), sc = *(const f32x4*)(mp + sc_off + c), sh = *(const f32x4*)(mp + sh_off + c);
        const f32x4 h = x * rstd * gv * (1.0f + sc) + sh;
        *(u32x2*)(H + (size_t)row * D + c) = (u32x2){cvt_pk_bf16(h[0], h[1]), cvt_pk_bf16(h[2], h[3])};
    }
    for (int row = gw; row < MP; row += nw) {
        bf16_t* hp = H + (size_t)row * D;
        f32x4 x[8]; float ss = 0.f;
        load_row(a, row, src_p, p_bf16, src_s, s_bf16, sr, lane, x);
#pragma unroll
        for (int i = 0; i < 8; ++i) ss += x[i][0] * x[i][0] + x[i][1] * x[i][1] + x[i][2] * x[i][2] + x[i][3] * x[i][3];
#pragma unroll
        for (int o = 32; o >= 1; o >>= 1) ss += __shfl_xor(ss, o);
        const float rstd = rsqrtf(ss * (1.0f / D) + EPS);
        const float* mp = MOD + (size_t)modrow_of(row) * NMOD;
#pragma unroll
        for (int hf = 0; hf < 2; ++hf) {
            f32x4 gv[4], sc[4], sh[4];
#pragma unroll
            for (int i = 0; i < 4; ++i) { const int c = 256 * (4 * hf + i) + 4 * lane; gv[i] = *(const f32x4*)(g + c); sc[i] = *(const f32x4*)(mp + sc_off + c); sh[i] = *(const f32x4*)(mp + sh_off + c); }
#pragma unroll
            for (int i = 0; i < 4; ++i) { const int c = 256 * (4 * hf + i) + 4 * lane;
                const f32x4 h = x[4 * hf + i] * rstd * gv[i] * (1.0f + sc[i]) + sh[i];
                __hip_atomic_store((unsigned long long*)(hp + c), ((unsigned long long)cvt_pk_bf16(h[2], h[3]) << 32) | cvt_pk_bf16(h[0], h[1]), __ATOMIC_RELAXED, __HIP_MEMORY_SCOPE_AGENT); }
        }
    }
}
__device__ __forceinline__ void final_phase(const Args& a, const SampleResid sr, int tid, LAS unsigned char* lds) {
    const bf16_t* X = (const bf16_t*)(a.ws + WS_X); const float* g = a.in[22];
    const int lane = tid & 63, gw = blockIdx.x * 8 + (tid >> 6), nw = gridDim.x * 8;
    for (int si = blockIdx.x; si < MS; si += gridDim.x) {
        const int wave = tid >> 6, c = 256 * wave + 4 * lane;
        f32x4 x;
        const float rstd = sample_row((LAS float*)lds, a, si, X + (size_t)MP * D, true, sr, wave, lane, x);
        __builtin_nontemporal_store(x * rstd * *(const f32x4*)(g + c), (f32x4*)(a.out + OUT_Y + (size_t)(MP + si) * D + c));
    }
    for (int row = gw; row < MP; row += nw) {
        float* yp = a.out + OUT_Y + (size_t)row * D;
        f32x4 x[8]; float ss = 0.f;
        load_row(a, row, X, true, X + (size_t)MP * D, true, sr, lane, x);
#pragma unroll
        for (int i = 0; i < 8; ++i) ss += x[i][0] * x[i][0] + x[i][1] * x[i][1] + x[i][2] * x[i][2] + x[i][3] * x[i][3];
#pragma unroll
        for (int o = 32; o >= 1; o >>= 1) ss += __shfl_xor(ss, o);
        const float rstd = rsqrtf(ss * (1.0f / D) + EPS);
        f32x4 gv[8];
#pragma unroll
        for (int i = 0; i < 8; ++i) gv[i] = *(const f32x4*)(g + 256 * i + 4 * lane);
#pragma unroll
        for (int i = 0; i < 8; ++i) { const int c = 256 * i + 4 * lane; __builtin_nontemporal_store(x[i] * rstd * gv[i], (f32x4*)(yp + c)); }
    }
}

constexpr int HP = 136, SP = 40, OBP = 132;
constexpr int L_QT = 0, L_QE = L_QT + 32 * HP * 2, L_KT = L_QE + 32 * HP * 2, L_KET = L_KT + 32 * HP * 2, L_VT = L_KET + 128 * SP * 2, L_ST = L_VT + 128 * SP * 2,
              L_ATT = L_ST + 128 * HP * 2, L_OB = L_ATT + 32 * SP * 2, L_PART = L_OB + 32 * OBP * 4, L_EB = L_PART + 4 * 128 * 4, L_HEND = L_EB + 128 * 4;
static_assert(L_HEND <= 131072, "hgrn lds");

#define LDSBAR() asm volatile("s_waitcnt lgkmcnt(0)\n\ts_barrier" ::: "memory")

constexpr int A_P = 136;
constexpr int LA_KET = 0, LA_VT = LA_KET + 128 * A_P * 2, LA_PART = LA_VT + 128 * A_P * 2, LA_EB = LA_PART + 4 * 128 * 4;
__device__ __forceinline__ void hgrn_passA(LAS unsigned char* lds, const Args& a, int bh, int j, int tid) {
    const int w = tid >> 6, lane = tid & 63, fr = lane & 15, fq = lane >> 4;
    const int kch = tid & 127, tq = tid >> 7;
    const int b = bh >> 3, h = bh & 7;
    const bf16_t* Kb = (const bf16_t*)(a.ws + WS_K); const bf16_t* Vb = (const bf16_t*)(a.ws + WS_V); const float* LF = (const float*)(a.ws + WS_LF);
    float* LLOC = (float*)(a.ws + WS_LLOC); float* DLOC = (float*)(a.ws + WS_DLOC);
    LAS bf16_t* KET = (LAS bf16_t*)(lds + LA_KET); LAS bf16_t* VT = (LAS bf16_t*)(lds + LA_VT); LAS float* PART = (LAS float*)(lds + LA_PART); LAS float* EB = (LAS float*)(lds + LA_EB);
    f32x4 accS[8];
#pragma unroll
    for (int kb = 0; kb < 8; ++kb) accS[kb] = (f32x4){0.f, 0.f, 0.f, 0.f};
    float btot = 0.f;
    const int row0 = b * SEQ + j * 256;
    const int vs = tid & 31, vc8 = tid >> 5;
#pragma unroll 1
    for (int c = 0; c < 2; ++c) {
        const int rowc = row0 + 128 * c;
        float cs[32], kk[32];
        {   const float* pl = LF + (size_t)(rowc + 32 * tq) * DA + 128 * h + kch; const bf16_t* pk = Kb + (size_t)(rowc + 32 * tq) * DA + 128 * h + kch;
#pragma unroll
            for (int i = 0; i < 32; ++i) { cs[i] = *pl; kk[i] = bf2f(*pk); pl += DA; pk += DA; asm("" : "+v"(pl), "+v"(pk)); } }
        u32x4 v16[4];
        {   const bf16_t* pv = Vb + (size_t)(rowc + vs) * DA + 128 * h + 8 * vc8;
#pragma unroll
            for (int i = 0; i < 4; ++i) { v16[i] = *(const u32x4*)pv; pv += 32 * DA; asm("" : "+v"(pv)); } }
#pragma unroll
        for (int i = 1; i < 32; ++i) cs[i] += cs[i - 1];
        PART[tq * 128 + kch] = cs[31];
#pragma unroll
        for (int i = 0; i < 4; ++i) {
            LAS bf16_t* p = VT + (8 * vc8) * A_P + vs + 32 * i;
            p[0] = (bf16_t)(v16[i].x & 0xffffu); p[A_P] = (bf16_t)(v16[i].x >> 16); p[2 * A_P] = (bf16_t)(v16[i].y & 0xffffu); p[3 * A_P] = (bf16_t)(v16[i].y >> 16);
            p[4 * A_P] = (bf16_t)(v16[i].z & 0xffffu); p[5 * A_P] = (bf16_t)(v16[i].z >> 16); p[6 * A_P] = (bf16_t)(v16[i].w & 0xffffu); p[7 * A_P] = (bf16_t)(v16[i].w >> 16);
        }
        LDSBAR();
        const float p0 = PART[kch], p1 = PART[128 + kch], p2 = PART[256 + kch], p3 = PART[384 + kch];
        const float offs = (tq > 0 ? p0 : 0.f) + (tq > 1 ? p1 : 0.f) + (tq > 2 ? p2 : 0.f);
        const float Bc = (p0 + p1) + (p2 + p3);
#pragma unroll
        for (int g8 = 0; g8 < 4; ++g8) {
            float ke[8];
#pragma unroll
            for (int e = 0; e < 8; ++e) ke[e] = kk[8 * g8 + e] * __expf(Bc - (offs + cs[8 * g8 + e]));
            *(LAS u32x4*)(KET + kch * A_P + 32 * tq + 8 * g8) = (u32x4){cvt_pk_bf16(ke[0], ke[1]), cvt_pk_bf16(ke[2], ke[3]), cvt_pk_bf16(ke[4], ke[5]), cvt_pk_bf16(ke[6], ke[7])};
        }
        if (tq == 0) EB[kch] = __expf(Bc);
        btot += Bc;
        LDSBAR();
#pragma unroll
        for (int kb = 0; kb < 8; ++kb) accS[kb] *= *(const LAS f32x4*)(EB + 16 * kb + 4 * fq);
#pragma unroll
        for (int ks = 0; ks < 4; ++ks) {
            const bf16x8 Bv = *(const LAS bf16x8*)(VT + (16 * w + fr) * A_P + 32 * ks + 8 * fq);
#pragma unroll
            for (int kb = 0; kb < 8; ++kb) {
                const bf16x8 A = *(const LAS bf16x8*)(KET + (16 * kb + fr) * A_P + 32 * ks + 8 * fq);
                accS[kb] = __builtin_amdgcn_mfma_f32_16x16x32_bf16(A, Bv, accS[kb], 0, 0, 0);
            }
        }
        LDSBAR();
    }
    float* Lp = LLOC + (size_t)(bh * 8 + j) * 128 * 128;
#pragma unroll
    for (int kb = 0; kb < 8; ++kb) *(f32x4*)(Lp + ((size_t)(w * 8 + kb) * 64 + lane) * 4) = accS[kb];
    if (tq == 0) DLOC[(size_t)(bh * 8 + j) * 128 + kch] = __expf(btot);
    __syncthreads();
}

#define HB_LOAD(cc, LFv, KKv, QQv, VV, GG) do { const int rc_ = row0 + 32 * (cc); \
    _Pragma("unroll") for (int i = 0; i < 8; ++i) { const size_t off_ = (size_t)(rc_ + 8 * tq + i) * DA + 128 * h + kch; LFv[i] = LF[off_]; KKv[i] = Kb[off_]; QQv[i] = Qb[off_]; } \
    VV = *(const u32x4*)(Vb + (size_t)(rc_ + vs2) * DA + 128 * h + 8 * vc82); GG = *(const u32x4*)(GT + (size_t)(rc_ + vs) * DA + 128 * h + 8 * vc8); } while (0)
__device__ __forceinline__ void hgrn_passB(LAS unsigned char* lds, const Args& a, int bh, int j, int tid) {
    const int w = tid >> 6, lane = tid & 63, fr = lane & 15, fq = lane >> 4;
    const int kch = tid & 127, tq = tid >> 7;
    const int b = bh >> 3, h = bh & 7;
    const bf16_t* Qb = (const bf16_t*)(a.ws + WS_Q); const bf16_t* Kb = (const bf16_t*)(a.ws + WS_K); const bf16_t* Vb = (const bf16_t*)(a.ws + WS_V);
    const bf16_t* GT = (const bf16_t*)(a.ws + WS_GT); const float* LF = (const float*)(a.ws + WS_LF);
    bf16_t* OMIX = (bf16_t*)(a.ws + WS_OMIX);
    const float* LLOC = (const float*)(a.ws + WS_LLOC); const float* DLOC = (const float*)(a.ws + WS_DLOC);
    LAS bf16_t* QT = (LAS bf16_t*)(lds + L_QT); LAS bf16_t* QE = (LAS bf16_t*)(lds + L_QE); LAS bf16_t* KT = (LAS bf16_t*)(lds + L_KT);
    LAS bf16_t* KET = (LAS bf16_t*)(lds + L_KET); LAS bf16_t* VT = (LAS bf16_t*)(lds + L_VT); LAS bf16_t* ST = (LAS bf16_t*)(lds + L_ST);
    LAS bf16_t* ATT = (LAS bf16_t*)(lds + L_ATT); LAS float* OB = (LAS float*)(lds + L_OB); LAS float* PART = (LAS float*)(lds + L_PART); LAS float* EB = (LAS float*)(lds + L_EB);
    const int row0 = b * SEQ + j * 256;
    const int vs = tid >> 4, vc8 = tid & 15;
    const int vs2 = tid & 31, vc82 = tid >> 5;
    float lf_c[8]; bf16_t kk_c[8], q_c[8]; u32x4 v_c, g_c;
    HB_LOAD(0, lf_c, kk_c, q_c, v_c, g_c);
    f32x4 accS[8];
#pragma unroll
    for (int kb = 0; kb < 8; ++kb) accS[kb] = (f32x4){0.f, 0.f, 0.f, 0.f};
    {
        LAS float* DL = OB;
        for (int t = tid; t < j * 128; t += NTHR) DL[t] = DLOC[(size_t)bh * 8 * 128 + t];
        __syncthreads();
        int jj = 0;
        for (; jj + 1 < j; jj += 2) {
            const float* L0 = LLOC + (size_t)(bh * 8 + jj) * 128 * 128 + ((size_t)(w * 8) * 64 + lane) * 4;
            f32x4 l0[8], l1[8];
#pragma unroll
            for (int kb = 0; kb < 8; ++kb) { l0[kb] = *(const f32x4*)(L0 + (size_t)kb * 256); l1[kb] = *(const f32x4*)(L0 + 128 * 128 + (size_t)kb * 256); }
#pragma unroll
            for (int kb = 0; kb < 8; ++kb) { const f32x4 d0 = *(const LAS f32x4*)(DL + jj * 128 + 16 * kb + 4 * fq), d1 = *(const LAS f32x4*)(DL + (jj + 1) * 128 + 16 * kb + 4 * fq);
                accS[kb] = d1 * (d0 * accS[kb] + l0[kb]) + l1[kb]; }
        }
        if (jj < j) {
            const float* L0 = LLOC + (size_t)(bh * 8 + jj) * 128 * 128 + ((size_t)(w * 8) * 64 + lane) * 4;
            f32x4 l0[8];
#pragma unroll
            for (int kb = 0; kb < 8; ++kb) l0[kb] = *(const f32x4*)(L0 + (size_t)kb * 256);
#pragma unroll
            for (int kb = 0; kb < 8; ++kb) { const f32x4 d0 = *(const LAS f32x4*)(DL + jj * 128 + 16 * kb + 4 * fq); accS[kb] = d0 * accS[kb] + l0[kb]; }
        }
    }
    const float* gn = a.in[14] + 128 * h + 8 * vc8;
    const f32x4 gn0 = *(const f32x4*)gn, gn1 = *(const f32x4*)(gn + 4);
#pragma unroll 1
    for (int c = 0; c < 8; ++c) {
        const int rowc = row0 + 32 * c;
        float lf_n[8]; bf16_t kk_n[8], q_n[8]; u32x4 v_n, g_n;
        if (c < 7) HB_LOAD(c + 1, lf_n, kk_n, q_n, v_n, g_n);
        else {
#pragma unroll
            for (int i = 0; i < 8; ++i) { lf_n[i] = 0.f; kk_n[i] = 0; q_n[i] = 0; }
            v_n = (u32x4){0u, 0u, 0u, 0u}; g_n = v_n;
        }
        float cs[8];
#pragma unroll
        for (int i = 0; i < 8; ++i) cs[i] = lf_c[i];
#pragma unroll
        for (int i = 1; i < 8; ++i) cs[i] += cs[i - 1];
        PART[tq * 128 + kch] = cs[7];
        {
            LAS bf16_t* p = VT + (8 * vc82) * SP + vs2;
            p[0] = (bf16_t)(v_c.x & 0xffffu); p[SP] = (bf16_t)(v_c.x >> 16); p[2 * SP] = (bf16_t)(v_c.y & 0xffffu); p[3 * SP] = (bf16_t)(v_c.y >> 16);
            p[4 * SP] = (bf16_t)(v_c.z & 0xffffu); p[5 * SP] = (bf16_t)(v_c.z >> 16); p[6 * SP] = (bf16_t)(v_c.w & 0xffffu); p[7 * SP] = (bf16_t)(v_c.w >> 16);
        }
#pragma unroll
        for (int kb = 0; kb < 8; ++kb)
            *(LAS u32x2*)(ST + (16 * w + fr) * HP + 16 * kb + 4 * fq) = (u32x2){cvt_pk_bf16(accS[kb][0], accS[kb][1]), cvt_pk_bf16(accS[kb][2], accS[kb][3])};
        LDSBAR();
        const float p0 = PART[kch], p1 = PART[128 + kch], p2 = PART[256 + kch], p3 = PART[384 + kch];
        const float offs = (tq > 0 ? p0 : 0.f) + (tq > 1 ? p1 : 0.f) + (tq > 2 ? p2 : 0.f);
        const float mref = p0 + p1, Bc = (p0 + p1) + (p2 + p3);
        float ke[8];
#pragma unroll
        for (int i = 0; i < 8; ++i) {
            const float bb = offs + cs[i], kkf = bf2f(kk_c[i]), qf = bf2f(q_c[i]);
            ke[i] = kkf * __expf(Bc - bb);
            const int t = 8 * tq + i;
            QT[t * HP + kch] = f2bf(qf * __expf(bb - mref));
            QE[t * HP + kch] = f2bf(qf * __expf(bb));
            KT[t * HP + kch] = f2bf(kkf * __expf(mref - bb));
        }
        *(LAS u32x4*)(KET + kch * SP + 8 * tq) = (u32x4){cvt_pk_bf16(ke[0], ke[1]), cvt_pk_bf16(ke[2], ke[3]), cvt_pk_bf16(ke[4], ke[5]), cvt_pk_bf16(ke[6], ke[7])};
        if (tq == 0) EB[kch] = __expf(Bc);
        LDSBAR();
        if (w < 4) {
            const int tb = w >> 1, sb = w & 1;
            f32x4 at = (f32x4){0.f, 0.f, 0.f, 0.f};
#pragma unroll
            for (int ks = 0; ks < 4; ++ks) {
                const bf16x8 A = *(const LAS bf16x8*)(QT + (16 * tb + fr) * HP + 32 * ks + 8 * fq);
                const bf16x8 B = *(const LAS bf16x8*)(KT + (16 * sb + fr) * HP + 32 * ks + 8 * fq);
                at = __builtin_amdgcn_mfma_f32_16x16x32_bf16(A, B, at, 0, 0, 0);
            }
#pragma unroll
            for (int i = 0; i < 4; ++i) { const int t = 16 * tb + 4 * fq + i, s = 16 * sb + fr; ATT[t * SP + s] = (s <= t) ? f2bf(at[i]) : (bf16_t)0; }
        }
        f32x4 ao[2] = {(f32x4){0.f, 0.f, 0.f, 0.f}, (f32x4){0.f, 0.f, 0.f, 0.f}};
#pragma unroll
        for (int ks = 0; ks < 4; ++ks) {
            const bf16x8 B = *(const LAS bf16x8*)(ST + (16 * w + fr) * HP + 32 * ks + 8 * fq);
#pragma unroll
            for (int tb = 0; tb < 2; ++tb) {
                const bf16x8 A = *(const LAS bf16x8*)(QE + (16 * tb + fr) * HP + 32 * ks + 8 * fq);
                ao[tb] = __builtin_amdgcn_mfma_f32_16x16x32_bf16(A, B, ao[tb], 0, 0, 0);
            }
        }
        LDSBAR();
        {
            const bf16x8 Bv = *(const LAS bf16x8*)(VT + (16 * w + fr) * SP + 8 * fq);
#pragma unroll
            for (int tb = 0; tb < 2; ++tb) {
                const bf16x8 A = *(const LAS bf16x8*)(ATT + (16 * tb + fr) * SP + 8 * fq);
                ao[tb] = __builtin_amdgcn_mfma_f32_16x16x32_bf16(A, Bv, ao[tb], 0, 0, 0);
#pragma unroll
                for (int i = 0; i < 4; ++i) OB[(16 * tb + 4 * fq + i) * OBP + 16 * w + fr] = ao[tb][i];
            }
#pragma unroll
            for (int kb = 0; kb < 8; ++kb) {
                const f32x4 eb = *(const LAS f32x4*)(EB + 16 * kb + 4 * fq);
                const bf16x8 A = *(const LAS bf16x8*)(KET + (16 * kb + fr) * SP + 8 * fq);
                accS[kb] = __builtin_amdgcn_mfma_f32_16x16x32_bf16(A, Bv, accS[kb] * eb, 0, 0, 0);
            }
        }
        LDSBAR();
        {
            const f32x4 o0 = *(const LAS f32x4*)(OB + vs * OBP + 8 * vc8), o1 = *(const LAS f32x4*)(OB + vs * OBP + 8 * vc8 + 4);
            float ss = o0[0] * o0[0] + o0[1] * o0[1] + o0[2] * o0[2] + o0[3] * o0[3] + o1[0] * o1[0] + o1[1] * o1[1] + o1[2] * o1[2] + o1[3] * o1[3];
            ss += __shfl_xor(ss, 1); ss += __shfl_xor(ss, 2); ss += __shfl_xor(ss, 4); ss += __shfl_xor(ss, 8);
            const float rstd = rsqrtf(ss * (1.0f / 128.0f) + EPS);
            u32x4 o;
            o.x = cvt_pk_bf16(o0[0] * rstd * gn0[0] * bf_lo(g_c.x), o0[1] * rstd * gn0[1] * bf_hi(g_c.x));
            o.y = cvt_pk_bf16(o0[2] * rstd * gn0[2] * bf_lo(g_c.y), o0[3] * rstd * gn0[3] * bf_hi(g_c.y));
            o.z = cvt_pk_bf16(o1[0] * rstd * gn1[0] * bf_lo(g_c.z), o1[1] * rstd * gn1[1] * bf_hi(g_c.z));
            o.w = cvt_pk_bf16(o1[2] * rstd * gn1[2] * bf_lo(g_c.w), o1[3] * rstd * gn1[3] * bf_hi(g_c.w));
            *(u32x4*)(OMIX + (size_t)(rowc + vs) * D + 128 * h + 8 * vc8) = o;
        }
#pragma unroll
        for (int i = 0; i < 8; ++i) { lf_c[i] = lf_n[i]; kk_c[i] = kk_n[i]; q_c[i] = q_n[i]; }
        v_c = v_n; g_c = g_n;
    }
    if (j == 7) {
        float* Sp = a.out + OUT_HP + (size_t)bh * 128 * 128;
#pragma unroll
        for (int kb = 0; kb < 8; ++kb)
#pragma unroll
            for (int i = 0; i < 4; ++i) Sp[(size_t)(16 * kb + 4 * fq + i) * 128 + 16 * w + fr] = accS[kb][i];
    }
    __syncthreads();
}

template <int NV>
__device__ __forceinline__ void block_reduce(LAS float* red, float (&v)[NV], int tid) {
    const int w = tid >> 6, lane = tid & 63;
#pragma unroll
    for (int i = 0; i < NV; ++i) {
#pragma unroll
        for (int o = 32; o >= 1; o >>= 1) v[i] += __shfl_xor(v[i], o);
    }
    __syncthreads();
    if (lane == 0) {
#pragma unroll
        for (int i = 0; i < NV; ++i) red[w * NV + i] = v[i];
    }
    __syncthreads();
#pragma unroll
    for (int i = 0; i < NV; ++i) { float s = 0.f;
#pragma unroll
        for (int ww = 0; ww < 8; ++ww) s += red[ww * NV + i];
        v[i] = s; }
}
__device__ __forceinline__ void conv_prompt_phase(LAS unsigned char* lds, const Args& a, int tid) {
    constexpr int T = 8;
    const bf16_t* U = (const bf16_t*)(a.ws + WS_U); bf16_t* OMIX = (bf16_t*)(a.ws + WS_OMIX);
    const float* cw = a.in[15]; const float* cb = a.in[16]; const float* lg = a.in[17]; const float* lb = a.in[18];
    const int c = 2 * tid;
    f32x2 wv[CW];
    { const char* pw = (const char*)(cw + c);
#pragma unroll
      for (int jx = 0; jx < CW; ++jx) { wv[jx] = *(const f32x2*)pw; pw += 4096; asm("" : "+v"(pw)); } }
    const f32x2 cbv = *(const f32x2*)(cb + c), lgv = *(const f32x2*)(lg + c), lbv = *(const f32x2*)(lb + c);
    const int vb = (gridDim.x % 8 == 0) ? (int)((blockIdx.x & 7) * (gridDim.x >> 3) + (blockIdx.x >> 3)) : (int)blockIdx.x;
#pragma unroll 1
    for (int unit = vb; unit < NBATCH * (SEQ / T); unit += gridDim.x) {
        const int b = unit / (SEQ / T), t0 = (unit % (SEQ / T)) * T, rbase = b * SEQ;
        f32x2 y[T];
#pragma unroll
        for (int t = 0; t < T; ++t) y[t] = cbv;
        const char* pu = (const char*)(U + ((long)rbase + t0 - 30) * DA + c);
#pragma unroll
        for (int r = 0; r < T + 30; ++r) {
            const int tok = t0 - 30 + r; unsigned x = 0u;
            if (tok >= 0) x = *(const unsigned*)pu;
            pu += DA * 2; asm("" : "+v"(pu));
            const f32x2 xv = (f32x2){bf_lo(x), bf_hi(x)};
#pragma unroll
            for (int t = 0; t < T; ++t) { const int jx = r - t; if (jx >= 0 && jx < CW) y[t] += wv[jx] * xv; }
        }
        float st[2 * T];
#pragma unroll
        for (int t = 0; t < T; ++t) { st[t] = y[t].x + y[t].y; st[T + t] = y[t].x * y[t].x + y[t].y * y[t].y; }
        block_reduce<2 * T>((LAS float*)lds, st, tid);
#pragma unroll
        for (int t = 0; t < T; ++t) {
            const float mean = st[t] * (1.0f / 1024.0f), var = fmaxf(st[T + t] * (1.0f / 1024.0f) - mean * mean, 0.f), rstd = rsqrtf(var + EPS);
            const float z0 = (y[t].x - mean) * rstd * lgv.x + lbv.x, z1 = (y[t].y - mean) * rstd * lgv.y + lbv.y;
            *(unsigned*)(OMIX + (size_t)(rbase + t0 + t) * D + 1024 + c) = cvt_pk_bf16(siluf_(z0), siluf_(z1));
        }
        __syncthreads();
    }
}
__device__ __forceinline__ void conv_sample_unit(LAS unsigned char* lds, const Args& a, int i, int tid) {
    const bf16_t* U = (const bf16_t*)(a.ws + WS_U); bf16_t* OMIX = (bf16_t*)(a.ws + WS_OMIX);
    const float* cw = a.in[15]; const float* cb = a.in[16]; const float* lg = a.in[17]; const float* lb = a.in[18];
    const float* sc = a.in[3] + (size_t)i * 30 * 1024; float* ncs = a.out + OUT_CS + (size_t)i * 30 * 1024;
    const int c = 2 * tid;
    const f32x2 cbv = *(const f32x2*)(cb + c);
    float y0 = cbv.x, y1 = cbv.y;
    const char* ps = (const char*)(sc + c); const char* pw = (const char*)(cw + c); char* pn = (char*)(ncs + c);
    f32x2 sv[30];
#pragma unroll
    for (int r = 0; r < 30; ++r) {
        sv[r] = *(const f32x2*)ps; const f32x2 wv = *(const f32x2*)pw;
        y0 += wv.x * sv[r].x; y1 += wv.y * sv[r].y;
        ps += 4096; pw += 4096; asm("" : "+v"(ps), "+v"(pw));
    }
#pragma unroll
    for (int r = 1; r < 30; ++r) { __builtin_nontemporal_store(sv[r], (f32x2*)pn); pn += 4096; asm("" : "+v"(pn)); }
    {
        const float* P = (const float*)(a.ws + WS_PART); const float* b_in = a.in[13];
        const int na = 4096 + (c >> 7) * 256 + (c & 127);
        f32x2 za = *(const f32x2*)(b_in + 4096 + c), zb = *(const f32x2*)(b_in + 5120 + c);
        f32x2 pa[NS_IN], pb[NS_IN];
#pragma unroll
        for (int sp = 0; sp < NS_IN; ++sp) { const float* pr = P + ((size_t)sp * 128 + i) * DIN + na; pa[sp] = *(const f32x2*)pr; pb[sp] = *(const f32x2*)(pr + 128); }
#pragma unroll
        for (int sp = 0; sp < NS_IN; ++sp) { za += pa[sp]; zb += pb[sp]; }
        const f32x2 uv = (f32x2){za.x * sigmoidf_(zb.x), za.y * sigmoidf_(zb.y)};
        *(f32x2*)(ncs + 29 * 1024 + c) = uv;
        const f32x2 wv = *(const f32x2*)pw; y0 += wv.x * uv.x; y1 += wv.y * uv.y; }
    float st[2] = {y0 + y1, y0 * y0 + y1 * y1};
    block_reduce<2>((LAS float*)lds, st, tid);
    const float mean = st[0] * (1.0f / 1024.0f), var = fmaxf(st[1] * (1.0f / 1024.0f) - mean * mean, 0.f), rstd = rsqrtf(var + EPS);
    const f32x2 lgv = *(const f32x2*)(lg + c), lbv = *(const f32x2*)(lb + c);
    const float z0 = (y0 - mean) * rstd * lgv.x + lbv.x, z1 = (y1 - mean) * rstd * lgv.y + lbv.y;
    *(unsigned*)(OMIX + (size_t)(MP + i) * D + 1024 + c) = cvt_pk_bf16(siluf_(z0), siluf_(z1));
    __syncthreads();
}
__device__ __forceinline__ void hgrn_sample_unit(LAS unsigned char* lds, const Args& a, int unit, int tid) {
    const int i = unit >> 3, h = unit & 7, row = MP + i;
    bf16_t* OMIX = (bf16_t*)(a.ws + WS_OMIX);
    const float* S0 = a.in[2] + (size_t)unit * 128 * 128; float* S1 = a.out + OUT_HS + (size_t)unit * 128 * 128;
    LAS float* RED = (LAS float*)lds;
    LAS float* R2 = (LAS float*)(lds + 8192);
    LAS float* ZQ = (LAS float*)(lds + 8448);
    const int v4 = tid & 31, kr = tid >> 5;
    f32x4 s0v[8];
#pragma unroll
    for (int ii = 0; ii < 8; ++ii) s0v[ii] = __builtin_nontemporal_load((const f32x4*)(S0 + (size_t)(kr + 16 * ii) * 128 + 4 * v4));
    {
        const float* P = (const float*)(a.ws + WS_PART); const float* b_in = a.in[13]; const float* lbl = a.in[6];
        const int which = tid >> 7, k = tid & 127, n = which * 1024 + 128 * h + k;
        float z = b_in[n]; float pz[NS_IN];
#pragma unroll
        for (int sp = 0; sp < NS_IN; ++sp) pz[sp] = P[((size_t)sp * 128 + i) * DIN + n];
#pragma unroll
        for (int sp = 0; sp < NS_IN; ++sp) z += pz[sp];
        if (which == 0) ZQ[k] = siluf_(z);
        else if (which == 1) { const float l0 = lbl[128 * h + k], l1 = lbl[1024 + 128 * h + k]; const float oml = 1.0f - 1.0f / (1.0f + __expf(l1 - l0));
            const float kk = oml * sigmoidf_(-z); ZQ[128 + k] = 1.0f - kk; ZQ[256 + k] = kk; }
        else if (which == 2) ZQ[384 + k] = z;
        else ZQ[512 + k] = siluf_(z);
    }
    __syncthreads();
    const f32x4 vv = *(const LAS f32x4*)(ZQ + 384 + 4 * v4);
    f32x4 acc = (f32x4){0.f, 0.f, 0.f, 0.f};
#pragma unroll
    for (int ii = 0; ii < 8; ++ii) {
        const int k = kr + 16 * ii;
        const float f = ZQ[128 + k], kkv = ZQ[256 + k], qk = ZQ[k];
        const f32x4 s0 = s0v[ii];
        const f32x4 sn = f * s0 + kkv * vv;
        __builtin_nontemporal_store(sn, (f32x4*)(S1 + (size_t)k * 128 + 4 * v4));
        acc += qk * sn;
    }
    *(LAS f32x4*)(RED + kr * 128 + 4 * v4) = acc;
    __syncthreads();
    float o = 0.f;
    if (tid < 128) {
#pragma unroll
        for (int r = 0; r < 16; ++r) o += RED[r * 128 + tid];
        float ss = o * o;
#pragma unroll
        for (int x = 32; x >= 1; x >>= 1) ss += __shfl_xor(ss, x);
        if ((tid & 63) == 0) R2[tid >> 6] = ss;
    }
    __syncthreads();
    if (tid < 128) {
        const float rstd = rsqrtf((R2[0] + R2[1]) * (1.0f / 128.0f) + EPS);
        OMIX[(size_t)row * D + 128 * h + tid] = f2bf(o * rstd * a.in[14][128 * h + tid] * ZQ[512 + tid]);
    }
    __syncthreads();
}


#define XB_TMO      128
#define XB_XCNT(j)  (256  + 64 * (j))
#define XB_XSUB(j)  (1280 + 64 * (j))
#define XB_XGEN(j)  (2304 + 64 * (j))
#define XB_TOP      3328
#define XB_TOPGEN   3392
#define XCD_BAR_WORDS 3456
#define XB_SPIN_CAP (1u << 18)
__device__ __forceinline__ unsigned xb_ld(unsigned* p)              { return __hip_atomic_load(p, __ATOMIC_RELAXED, __HIP_MEMORY_SCOPE_AGENT); }
__device__ __forceinline__ unsigned xb_add(unsigned* p, unsigned v) { return __hip_atomic_fetch_add(p, v, __ATOMIC_RELAXED, __HIP_MEMORY_SCOPE_AGENT); }
__device__ __forceinline__ unsigned xb_xcc_id() { return (unsigned)__builtin_amdgcn_s_getreg((3 << 11) | 20) & 0xFu; }
#define XB_SPIN(cond, bar) do { unsigned _sp = 0; while (cond) { __builtin_amdgcn_s_sleep(1); \
    if ((++_sp & 255u) == 0u) { if (xb_ld(&(bar)[XB_TMO])) break; if (_sp > XB_SPIN_CAP) { atomicAdd(&(bar)[XB_TMO], 1u); break; } } } } while (0)
struct XcdBarrier { unsigned* bar; unsigned x; volatile LAS unsigned* st; };
__device__ __forceinline__ XcdBarrier xcd_barrier_post(unsigned* bar, volatile LAS unsigned* st) {
    XcdBarrier b; b.bar = bar; b.x = xb_xcc_id(); b.st = st;
    if (threadIdx.x == 0) (void)xb_add(&bar[XB_XCNT(b.x)], 1u);
    return b;
}
__device__ __forceinline__ void xcd_barrier_complete(unsigned* bar, unsigned x, unsigned& nloc, unsigned& nx) {
    const unsigned G = gridDim.x * gridDim.y * gridDim.z;
    unsigned sum, cnt, mine, sp = 0u;
    for (;;) {
        sum = 0u; cnt = 0u; mine = 0u;
#pragma unroll
        for (unsigned j = 0; j < 16; ++j) { const unsigned c = xb_ld(&bar[XB_XCNT(j)]); sum += c; cnt += (c > 0u) ? 1u : 0u; mine = (j == x) ? c : mine; }
        if (sum == G) break;
        __builtin_amdgcn_s_sleep(1);
        if ((++sp & 255u) == 0u) { if (xb_ld(&bar[XB_TMO])) break; if (sp > XB_SPIN_CAP) { atomicAdd(&bar[XB_TMO], 1u); break; } }
    }
    nloc = mine > 0u ? mine : 1u; nx = cnt > 0u ? cnt : 1u;
}
__device__ __forceinline__ void xcd_barrier(const XcdBarrier& b) {
    asm volatile("s_waitcnt vmcnt(0)" ::: "memory");
    __syncthreads();
    if (threadIdx.x == 0) {
        unsigned* bar = b.bar;
        __builtin_amdgcn_s_waitcnt(0);
        unsigned nloc = b.st[0], nx = b.st[1];
        if (nloc == 0u) { xcd_barrier_complete(bar, b.x, nloc, nx); b.st[0] = nloc; b.st[1] = nx; }
        const unsigned old = xb_add(&bar[XB_XSUB(b.x)], 1u);
        const unsigned gen = old / nloc;
        if (old + 1u == (gen + 1u) * nloc) {
            __builtin_amdgcn_fence(__ATOMIC_RELEASE, "agent");
            asm volatile("s_waitcnt vmcnt(0)" ::: "memory");
            const unsigned og = xb_add(&bar[XB_TOP], 1u);
            const unsigned tg = og / nx;
            if (og + 1u == (tg + 1u) * nx) xb_add(&bar[XB_TOPGEN], 1u);
            else XB_SPIN(xb_ld(&bar[XB_TOPGEN]) == tg, bar);
            __builtin_amdgcn_fence(__ATOMIC_ACQUIRE, "agent");
            xb_add(&bar[XB_XGEN(b.x)], 1u);
            asm volatile("s_waitcnt vmcnt(0)" ::: "memory");
        } else {
            XB_SPIN(xb_ld(&bar[XB_XGEN(b.x)]) == gen, bar);
            __builtin_amdgcn_fence(__ATOMIC_ACQUIRE, "agent");
            asm volatile("s_waitcnt vmcnt(0)" ::: "memory");
        }
    }
    __syncthreads();
}

#ifndef PHMASK
#define PHMASK 0xFFFF
#endif
#define PH(k) if ((PHMASK >> (k)) & 1)
#ifndef REPMASK
#define REPMASK 0
#endif
#define REP(k)
__global__ void __launch_bounds__(NTHR, 2) hymba_fwd(Args a) {
    extern __shared__ __attribute__((aligned(16))) unsigned char shm[];
    LAS unsigned char* lds = (LAS unsigned char*)shm;
    cg::grid_group grid = cg::this_grid();
    int tid = threadIdx.x; const int bx = blockIdx.x, G = gridDim.x;
#define LAUNDER() asm volatile("" : "+v"(tid))
#define GSYNC() do { xcd_barrier(xb); LAUNDER(); } while (0)
    if (tid < 4) ((LAS unsigned*)(lds + 131072))[tid] = 0u;
    __syncthreads();
    const XcdBarrier xb = xcd_barrier_post((unsigned*)(a.ws + WS_BAR), (volatile LAS unsigned*)(lds + 131072));
    if (a.never) grid.sync();
    unsigned char* ws = a.ws;
    const float* MOD = (const float*)(ws + WS_MOD);
    bf16_t* H = (bf16_t*)(ws + WS_H); bf16_t* Gb = (bf16_t*)(ws + WS_G); bf16_t* X = (bf16_t*)(ws + WS_X); bf16_t* OMIX = (bf16_t*)(ws + WS_OMIX); float* PART = (float*)(ws + WS_PART);

    REP(0) {
    if (!(bx & 1)) { for (int u = bx; u < 256; u += G) ada_unit(lds, a, u, tid); }
    convert_range(lds, a, 0, (G == 256) ? CT_P0 : CT_EARLY, bx, G, tid);
    if (bx & 1) { for (int u = bx; u < 256; u += G) ada_unit(lds, a, u, tid); }
    GSYNC();
    }
    PH(1) rows_phase(a, a.in[0], false, a.in[1], false, a.in[9], 0 * D, 1 * D, true, SampleResid{nullptr, 0, 0, 0.f}, tid, lds);
    GSYNC();
    REP(2) {
    PH(2) { pg8::Gemm g{H, (const bf16_t*)(ws + WS_WUP1), MP, 2 * DFF, D}; pg8::StaticOrder S; S.init(MP, 2 * DFF, D, G, bx, 1); EpiSwiGLU E{Gb};
      pg8::gemm_phase(lds, g, S, E); }
    { int first = bx, stride = G;
      if (G == 256) { first = bx - 172; stride = 84; }
      if (first >= 0) convert_range(lds, a, CT_EARLY, CT_MID, first, stride, tid); }
    GSYNC();
    }
    REP(3) {
    PH(3) { pg8::Gemm g{Gb, (const bf16_t*)(ws + WS_WDN1), MP, D, DFF}; pg8::StaticOrder S; S.init(MP, D, DFF, G, bx, NS_DN); EpiResid<false> E{a.in[0], X, MOD + 2 * D, 0.5f, PART};
      pg8::gemm_phase(lds, g, S, E); }
    if (G == 256 && bx >= NS_DN * 8) convert_range(lds, a, CT_P0, CT_I3, bx - NS_DN * 8, 256 - NS_DN * 8, tid);
    GSYNC();
    }
    PH(4) rows_phase(a, X, true, a.in[1], false, a.in[9] + D, 3 * D, 4 * D, false, SampleResid{PART, NS_DN, 2 * D, 0.5f}, tid, lds);
    GSYNC();
    REP(5) {
    PH(5) { pg8::Gemm g{H, (const bf16_t*)(ws + WS_WIN), MP, DIN, D}; pg8::StaticOrder S; S.init(MP, DIN, D, G, bx, NS_IN);
      EpiWin E{(bf16_t*)(ws + WS_Q), (bf16_t*)(ws + WS_K), (bf16_t*)(ws + WS_V), (bf16_t*)(ws + WS_GT), (bf16_t*)(ws + WS_U), (float*)(ws + WS_LF), a.in[13], a.in[6], a.out + OUT_CP, PART};
      pg8::gemm_phase(lds, g, S, E); }
    if (G == 256 && bx >= NS_IN * 24) convert_range(lds, a, CT_I3, CT_I5, bx - NS_IN * 24, 256 - NS_IN * 24, tid);
    GSYNC();
    }
#define HGRN_SAMPLE_UNITS() do { \
        if (G == 256) { const int nmine_ = bx < 128 ? 3 : 5; for (int k_ = 0; k_ < nmine_; ++k_) { const int u_ = (k_ < 4) ? bx + 256 * k_ : bx - 128 + 768; hgrn_sample_unit(lds, a, u_, tid); } } \
        else { for (int u_ = bx; u_ < MS * NH; u_ += G) hgrn_sample_unit(lds, a, u_, tid); } } while (0)
    REP(6) {
    if (bx & 1) { HGRN_SAMPLE_UNITS(); }
    const int vbx = (G % 8 == 0) ? (bx & 7) * (G >> 3) + (bx >> 3) : bx;
    PH(6) for (int u = vbx; u < 256; u += G) hgrn_passA(lds, a, u >> 3, u & 7, tid);
    PH(14) conv_prompt_phase(lds, a, tid);
    PH(15) for (int u = bx; u < MS; u += G) conv_sample_unit(lds, a, u, tid);
    if (!(bx & 1)) { HGRN_SAMPLE_UNITS(); }
    GSYNC();
    PH(7) for (int u = vbx; u < 256; u += G) hgrn_passB(lds, a, u >> 3, u & 7, tid);
    GSYNC();
    }
    PH(8) { pg8::Gemm g{OMIX, (const bf16_t*)(ws + WS_WOUT), MP, D, D}; pg8::StaticOrder S; S.init(MP, D, D, G, bx, NS_OUT); EpiResid<true> E{X, X, MOD + 5 * D, 1.0f, PART};
      pg8::gemm_phase(lds, g, S, E); }
    if (G == 256 && bx >= NS_OUT * 8) convert_range(lds, a, CT_I5, CT2, bx - NS_OUT * 8, 256 - NS_OUT * 8, tid);
    GSYNC();
    PH(9) rows_phase(a, X, true, X + (size_t)MP * D, true, a.in[9] + 2 * D, 6 * D, 7 * D, false, SampleResid{PART, NS_OUT, 5 * D, 1.0f}, tid, lds);
    GSYNC();
    PH(10) { pg8::Gemm g{H, (const bf16_t*)(ws + WS_WUP2), MP, 2 * DFF, D}; pg8::StaticOrder S; S.init(MP, 2 * DFF, D, G, bx, 1); EpiSwiGLU E{Gb};
      pg8::gemm_phase(lds, g, S, E); }
    { int first = bx, stride = G;
      if (G == 256) { first = bx - 172; stride = 84; }
      if (first >= 0) convert_range(lds, a, CT_MID, CT_ALL, first, stride, tid); }
    GSYNC();
    PH(11) { pg8::Gemm g{Gb, (const bf16_t*)(ws + WS_WDN2), MP, D, DFF}; pg8::StaticOrder S; S.init(MP, D, DFF, G, bx, NS_DN); EpiResid<true> E{X, X, MOD + 8 * D, 0.5f, PART};
      pg8::gemm_phase(lds, g, S, E); }
    GSYNC();
    final_phase(a, SampleResid{PART, NS_DN, 8 * D, 0.5f}, tid, lds);
}

extern "C" void kernel_launch(void* const* d_in, const int* in_sizes, int n_in, void* d_out, int out_size, void* d_ws, size_t ws_size, hipStream_t stream) {
    constexpr int LDS_BYTES = 131072 + 1024;
    static int grid = 0;
    if (!grid) {
        int dev = 0, cus = 0, per_cu = 0;
        (void)hipGetDevice(&dev);
        (void)hipDeviceGetAttribute(&cus, hipDeviceAttributeMultiprocessorCount, dev);
        (void)hipFuncSetAttribute((const void*)hymba_fwd, hipFuncAttributeMaxDynamicSharedMemorySize, LDS_BYTES);
        (void)hipOccupancyMaxActiveBlocksPerMultiprocessor(&per_cu, (const void*)hymba_fwd, NTHR, LDS_BYTES);
        if (ws_size < WS_END || n_in != 23) { fprintf(stderr, "kernel_launch: ws %zu < %zu or n_in %d\n", ws_size, (size_t)WS_END, n_in); grid = -1; return; }
        grid = cus > 0 ? cus : 256;
        fprintf(stderr, "kernel_launch: cus %d per_cu %d grid %d\n", cus, per_cu, grid);
    }
    if (grid < 0) return;
    (void)hipMemsetAsync((unsigned char*)d_ws + WS_BAR, 0, 16384, stream);
    Args a{};
    for (int i = 0; i < 23; ++i) a.in[i] = (const float*)d_in[i];
    a.out = (float*)d_out; a.ws = (unsigned char*)d_ws;
    void* args[] = {&a};
    hipError_t e = hipLaunchCooperativeKernel((const void*)hymba_fwd, dim3(grid), dim3(NTHR), args, LDS_BYTES, stream);
    if (e != hipSuccess) fprintf(stderr, "kernel_launch: cooperative launch failed: %s (grid %d)\n", hipGetErrorString(e), grid);
}
```
